# Optimizing an MI355X kernel written in HIP

```python
import math
import jax, jax.numpy as jnp
from jax import lax
import numpy as np

D_MODEL = 1024
BATCH = 2
SEQ = 8192
DEPTH = 2

D_MIX = D_MODEL
HEAD_DIM = 64
RWKV_WIDTH = D_MIX // 2
SB_WIDTH = D_MIX - RWKV_WIDTH
RWKV_HEADS = RWKV_WIDTH // HEAD_DIM
SB_HEADS = SB_WIDTH // HEAD_DIM
DECAY_LORA = 64
ICLR_LORA = 64
SHIFT_COLS = 3 * RWKV_WIDTH + DECAY_LORA + ICLR_LORA
RWKV_COLS = SHIFT_COLS + RWKV_WIDTH
SB_COLS = 4 * SB_WIDTH
IN_COLS = RWKV_COLS + SB_COLS
Q_BLOCK = 128
NORM_EPS = 1e-6
GN_EPS = 64e-5

kernel_name = "hymba_rwkv7_stickbreaking_adaln"


def rmsnorm(x, g):
    xf = x.astype(jnp.float32)
    y = xf * lax.rsqrt(jnp.mean(xf * xf, axis=-1, keepdims=True) + NORM_EPS)
    return (y * g.astype(jnp.float32)).astype(x.dtype)


def rwkv7_group(p, mu, w0, w2, a0, a2, k_k, k_a, r_k, ln_w, ln_b):
    B, S, _ = p.shape
    H, N = RWKV_HEADS, HEAD_DIM
    ps, g = p[..., :SHIFT_COLS], p[..., SHIFT_COLS:]
    prev = jnp.pad(ps, ((0, 0), (1, 0), (0, 0)))[:, :-1]
    ps = ps + (prev - ps) * mu
    r, k, v, zw, za = jnp.split(
        ps, [RWKV_WIDTH, 2 * RWKV_WIDTH, 3 * RWKV_WIDTH, 3 * RWKV_WIDTH + DECAY_LORA], axis=-1)
    w_log = -jax.nn.softplus(-(w0 + jnp.tanh(zw) @ w2)) - 0.5
    decay = jnp.exp(-jnp.exp(w_log.astype(jnp.float32)))
    a = jax.nn.sigmoid(a0 + za @ a2)
    hd = lambda t: t.reshape(B, S, H, N)
    r, k, v, decay, a = hd(r), hd(k), hd(v), hd(decay), hd(a)
    kk = hd(ps[..., RWKV_WIDTH:2 * RWKV_WIDTH] * k_k)
    kkf = kk.astype(jnp.float32)
    kk = kkf * lax.rsqrt(jnp.maximum(jnp.sum(kkf * kkf, axis=-1, keepdims=True), 1e-24))
    k = k * (1.0 + (a - 1.0) * k_a.reshape(H, N))

    def step(state, inp):
        r_t, w_t, k_t, v_t, kk_t, b_t = inp
        sa = jnp.einsum('bhij,bhj->bhi', state, -kk_t)
        state = (state * w_t[:, :, None, :]
                 + sa[..., None] * b_t[:, :, None, :]
                 + v_t[..., None] * k_t[:, :, None, :])
        y_t = jnp.einsum('bhij,bhj->bhi', state, r_t)
        return state, y_t

    tm = lambda t: jnp.moveaxis(t.astype(jnp.float32), 1, 0)
    state0 = jnp.zeros((B, H, N, N), jnp.float32)
    _, y = lax.scan(step, state0, (tm(r), tm(decay), tm(k), tm(v), tm(kk), tm(kk * a)))
    y = jnp.moveaxis(y, 0, 1)
    mean = jnp.mean(y, axis=-1, keepdims=True)
    var = jnp.mean(jnp.square(y - mean), axis=-1, keepdims=True)
    y = (y - mean) * lax.rsqrt(var + GN_EPS)
    y = y * ln_w.reshape(H, N) + ln_b.reshape(H, N)
    rf, kf, vf = r.astype(jnp.float32), k.astype(jnp.float32), v.astype(jnp.float32)
    y = y + jnp.sum(rf * kf * r_k, axis=-1, keepdims=True) * vf
    y = y.reshape(B, S, RWKV_WIDTH).astype(p.dtype)
    return y * jax.nn.silu(g)


def stick_breaking_group(p, sb_g):
    B, S, _ = p.shape
    H, N = SB_HEADS, HEAD_DIM
    n_blocks = S // Q_BLOCK
    q, k, v, g = jnp.split(p, 4, axis=-1)
    hd = lambda t: t.reshape(B, S, H, N).transpose(0, 2, 1, 3)
    q, k, v = hd(q), hd(k), hd(v)
    scale = 1.0 / math.sqrt(N)
    k_pos = jnp.arange(S)
    q_blocks = q.reshape(B, H, n_blocks, Q_BLOCK, N).transpose(2, 0, 1, 3, 4)

    def block(args):
        q_blk, idx = args
        q_pos = idx * Q_BLOCK + jnp.arange(Q_BLOCK)
        z = jnp.einsum('bhqd,bhkd->bhqk', q_blk, k).astype(jnp.float32) * scale
        mask = k_pos[None, :] < q_pos[:, None]
        log_1m = jnp.where(mask, jax.nn.log_sigmoid(-z), 0.0)
        after = lax.cumsum(log_1m, axis=3, reverse=True) - log_1m
        attn = jnp.where(mask, jnp.exp(jax.nn.log_sigmoid(z) + after), 0.0)
        return jnp.einsum('bhqk,bhkd->bhqd', attn.astype(v.dtype), v)

    o = lax.map(block, (q_blocks, jnp.arange(n_blocks)))
    o = o.transpose(1, 3, 0, 2, 4).reshape(B, S, H, N)
    o = rmsnorm(o, sb_g.reshape(H, N)).reshape(B, S, SB_WIDTH)
    return o * jax.nn.silu(g)


def setup_inputs(seed: int = 0) -> dict:
    key = jax.random.key(seed)
    ks = jax.random.split(key, 20)
    nrm = lambda k, shape, s: s * jax.random.normal(k, shape, jnp.float32)
    return {
        "x": nrm(ks[0], (BATCH, SEQ, D_MODEL), 1.0),
        "c": nrm(ks[1], (BATCH, D_MODEL), 1.0),
        "norm_g": 1.0 + nrm(ks[2], (DEPTH, D_MODEL), 0.05),
        "ada_w": nrm(ks[3], (DEPTH, D_MODEL, 3 * D_MODEL), 0.5 * D_MODEL ** -0.5),
        "ada_b": nrm(ks[4], (DEPTH, 3 * D_MODEL), 0.02),
        "w_in": nrm(ks[5], (DEPTH, D_MODEL, IN_COLS), D_MODEL ** -0.5),
        "w_out": nrm(ks[6], (DEPTH, D_MIX, D_MODEL), D_MIX ** -0.5),
        "tshift_mu": jax.random.uniform(ks[7], (DEPTH, SHIFT_COLS), jnp.float32),
        "decay_w0": jax.random.uniform(ks[8], (DEPTH, RWKV_WIDTH), jnp.float32, minval=-4.0, maxval=1.0),
        "decay_w2": nrm(ks[9], (DEPTH, DECAY_LORA, RWKV_WIDTH), 0.5 * DECAY_LORA ** -0.5),
        "iclr_a0": nrm(ks[10], (DEPTH, RWKV_WIDTH), 0.5),
        "iclr_a2": nrm(ks[11], (DEPTH, ICLR_LORA, RWKV_WIDTH), 0.5 * ICLR_LORA ** -0.5),
        "k_k": 0.85 + nrm(ks[12], (DEPTH, RWKV_WIDTH), 0.05),
        "k_a": 1.0 + nrm(ks[13], (DEPTH, RWKV_WIDTH), 0.05),
        "r_k": nrm(ks[14], (DEPTH, RWKV_HEADS, HEAD_DIM), 0.1),
        "rwkv_ln_w": 1.0 + nrm(ks[15], (DEPTH, RWKV_WIDTH), 0.05),
        "rwkv_ln_b": nrm(ks[16], (DEPTH, RWKV_WIDTH), 0.02),
        "sb_norm_g": 1.0 + nrm(ks[17], (DEPTH, SB_WIDTH), 0.05),
        "final_g": 1.0 + nrm(ks[18], (D_MODEL,), 0.05),
    }


def reference(x, c, norm_g, ada_w, ada_b, w_in, w_out, tshift_mu, decay_w0, decay_w2,
              iclr_a0, iclr_a2, k_k, k_a, r_k, rwkv_ln_w, rwkv_ln_b, sb_norm_g, final_g):
    c_act = jax.nn.silu(c)
    for l in range(DEPTH):
        mod = c_act @ ada_w[l] + ada_b[l]
        shift, scale, gate = jnp.split(mod, 3, axis=-1)
        h = rmsnorm(x, norm_g[l]) * (1.0 + scale[:, None, :]) + shift[:, None, :]
        p = h @ w_in[l]
        y_rwkv = rwkv7_group(p[..., :RWKV_COLS], tshift_mu[l], decay_w0[l], decay_w2[l],
                             iclr_a0[l], iclr_a2[l], k_k[l], k_a[l], r_k[l],
                             rwkv_ln_w[l], rwkv_ln_b[l])
        y_sb = stick_breaking_group(p[..., RWKV_COLS:], sb_norm_g[l])
        y = jnp.concatenate([y_rwkv, y_sb], axis=-1) @ w_out[l]
        x = x + gate[:, None, :] * y
    return rmsnorm(x, final_g)
```

```cpp
#include <hip/hip_runtime.h>
#include <hip/hip_cooperative_groups.h>
#include <cstdio>
#include <cstdint>
namespace cg = cooperative_groups;
namespace pg8 {
#define PG8_LAS __attribute__((address_space(3)))
typedef unsigned short bf16_t;
typedef short bf16x8 __attribute__((ext_vector_type(8)));
typedef float f32x4 __attribute__((ext_vector_type(4)));
typedef unsigned u32x4 __attribute__((ext_vector_type(4)));
constexpr int BM = 256, BK = 64, HALF = 128, HTB = HALF * BK * 2  , STAGE_BYTES = 8 * HTB, NXCD = 8, WGM = 8;

__host__ __device__ __forceinline__ int lds_byte(int r, int c) { const int st = (r >> 4) * 2 + (c >> 5), rr = r & 15, cc = c & 31, ob = rr * 64 + cc * 2; return st * 1024 + (ob ^ (((ob >> 9) & 1) << 5)); }
__host__ __device__ __forceinline__ void stage_rc(int b, int& R, int& C) { const int st = b / 1024, sb = b % 1024, swz = sb ^ (((sb >> 9) & 1) << 5); R = (st >> 1) * 16 + swz / 64; C = (st & 1) * 32 + (swz % 64) / 2; }
__host__ __device__ __forceinline__ int perm32(int rho) { const int n = rho >> 4, i = rho & 15; return 8 * (i >> 2) + 4 * n + (i & 3); }

struct Unit { int pm, pn; };
struct Gemm { const bf16_t* A; const bf16_t* Bt; int M, N, K; };

struct StaticOrder {
    int nM, nN, nwg, G, c;
    __host__ __device__ void init(int M, int N, int G_, int c_) { nM = M / BM; nN = N / BM; nwg = nM * nN; G = G_; c = c_; }
    __host__ __device__ bool next(int i, Unit& u) const {
        const long L = (long)i * G + c; if (L >= nwg) return false;
        int wgid = (int)L; { const int q = nwg / NXCD, r = nwg % NXCD, xcd = wgid % NXCD, off = wgid / NXCD; wgid = (xcd < r ? xcd * (q + 1) : r * (q + 1) + (xcd - r) * q) + off; }
        const int nig = WGM * nN, gid = wgid / nig, fm = gid * WGM, gsz = (nM - fm) < WGM ? (nM - fm) : WGM;
        u.pm = fm + ((wgid % nig) % gsz); u.pn = (wgid % nig) / gsz; return true;
    }
    __device__ __forceinline__ void a_ready(const Unit&) const {}
    __device__ __forceinline__ void done(const Unit&) const {}
};

typedef __bf16 bf16v2_t __attribute__((ext_vector_type(2)));
typedef float f32v2_t __attribute__((ext_vector_type(2)));
__device__ __forceinline__ unsigned cvt_pk_bf16(float lo, float hi) { f32v2_t v = {lo, hi}; bf16v2_t b = __builtin_convertvector(v, bf16v2_t); return __builtin_bit_cast(unsigned, b); }
struct EpiBf16 {
    static constexpr bool PERM = true, AFTER_DRAIN = false;
    bf16_t* O; int ldc;
    __device__ __forceinline__ void operator()(const f32x4 (&acc)[2][2][4][2], const Unit& u, int wr, int wc, int fr, int fq) const {
        const int row0 = u.pm * BM + wr * 64 + fr; const int col0 = u.pn * BM + wc * 32 + 8 * fq;
#pragma unroll
        for (int ai = 0; ai < 2; ++ai)
#pragma unroll
            for (int m = 0; m < 4; ++m) { bf16_t* rowp = O + (size_t)(row0 + ai * HALF + m * 16) * ldc + col0;
#pragma unroll
                for (int bj = 0; bj < 2; ++bj) { const f32x4 v0 = acc[ai][bj][m][0], v1 = acc[ai][bj][m][1];
                    u32x4 w; w.x = cvt_pk_bf16(v0[0], v0[1]); w.y = cvt_pk_bf16(v0[2], v0[3]); w.z = cvt_pk_bf16(v1[0], v1[1]); w.w = cvt_pk_bf16(v1[2], v1[3]);
                    *(u32x4*)(rowp + bj * HALF) = w; } }
    }
    __device__ __forceinline__ void fused(f32x4 (&)[2][2][4][2], const Unit&, int, int, int, int, PG8_LAS unsigned char*, int, int) const {}
};
struct EpiRes {
    static constexpr bool PERM = false, AFTER_DRAIN = false;
    const float* xin; float* out; const float* gate;
    __device__ __forceinline__ void operator()(const f32x4 (&acc)[2][2][4][2], const Unit& u, int wr, int wc, int fr, int fq) const {
        const int row0 = u.pm * BM + wr * 64 + fr; const int col0 = u.pn * BM + wc * 32 + 4 * fq; const float* gp = gate + ((u.pm * BM) >> 13) * 1024;
        f32x4 gv[2][2];
#pragma unroll
        for (int bj = 0; bj < 2; ++bj)
#pragma unroll
            for (int n = 0; n < 2; ++n) gv[bj][n] = *(const f32x4*)(gp + col0 + bj * HALF + n * 16);
#pragma unroll
        for (int ai = 0; ai < 2; ++ai)
#pragma unroll
            for (int m = 0; m < 4; ++m) { const size_t off = (size_t)(row0 + ai * HALF + m * 16) * 1024 + col0;
#pragma unroll
                for (int bj = 0; bj < 2; ++bj)
#pragma unroll
                    for (int n = 0; n < 2; ++n) { const f32x4 xv = *(const f32x4*)(xin + off + bj * HALF + n * 16);
                        *(f32x4*)(out + off + bj * HALF + n * 16) = xv + gv[bj][n] * acc[ai][bj][m][n]; } }
    }
    __device__ __forceinline__ void fused(f32x4 (&)[2][2][4][2], const Unit&, int, int, int, int, PG8_LAS unsigned char*, int, int) const {}
};
template <class Epi, class Sched, bool ALIGN_EPI = false, bool SP2 = false>
__device__ __forceinline__ void gemm_phase(PG8_LAS unsigned char* lds, const Gemm g, const Sched& S, const Epi& E) {
    const int tid = threadIdx.x, wid = __builtin_amdgcn_readfirstlane(tid >> 6), lane = tid & 63, wr = wid >> 2, wc = wid & 3, fr = lane & 15, fq = lane >> 4;
    const int K = g.K, nt = K / BK;
    unsigned voffA[2], voffB[2];
#pragma unroll
    for (int i = 0; i < 2; ++i) { int R, C; stage_rc(tid * 16 + i * 8192, R, C); const int Rb = Epi::PERM ? ((R & ~31) + perm32(R & 31)) : R;
        voffA[i] = (unsigned)(R * K + C) * 2u; voffB[i] = (unsigned)(Rb * K + C) * 2u; }
    const size_t kstep = (size_t)(BK * 2);
    const size_t hstep = (size_t)HALF * K * 2;
    const size_t tstep = 2 * hstep;
    const unsigned ldsw = (unsigned)wid * 1024u;
    const int aoff = lds_byte(wr * 64 + fr, fq * 8), boff = lds_byte(wc * 32 + fr, fq * 8);
#define PG8_SA(b, h) (((b) * 2 + (h)) * HTB)
#define PG8_SB(b, h) ((4 + (b) * 2 + (h)) * HTB)
#define PG8_STAGE(bufoff, gbase, voff) do { _Pragma("unroll") for (int _i = 0; _i < 2; ++_i) \
        __builtin_amdgcn_global_load_lds((const unsigned*)((const char*)(gbase) + (voff)[_i]), (PG8_LAS unsigned*)(lds + (bufoff) + ldsw + _i * 8192), 16, 0, 0); } while (0)
#define PG8_LDA(dst, b, h) do { _Pragma("unroll") for (int m = 0; m < 4; ++m) _Pragma("unroll") for (int k = 0; k < 2; ++k) dst[m][k] = *(const PG8_LAS bf16x8*)(lds + PG8_SA(b, h) + aoff + m * 2048 + k * 1024); } while (0)
#define PG8_LDB(dst, b, h) do { _Pragma("unroll") for (int n = 0; n < 2; ++n) _Pragma("unroll") for (int k = 0; k < 2; ++k) dst[n][k] = *(const PG8_LAS bf16x8*)(lds + PG8_SB(b, h) + boff + n * 2048 + k * 1024); } while (0)
#define PG8_MMA(ai, bj, At, Bt) do { __builtin_amdgcn_s_setprio(1); _Pragma("unroll") for (int m = 0; m < 4; ++m) _Pragma("unroll") for (int n = 0; n < 2; ++n) _Pragma("unroll") for (int k = 0; k < 2; ++k) \
        acc[ai][bj][m][n] = __builtin_amdgcn_mfma_f32_16x16x32_bf16(Bt[n][k], At[m][k], acc[ai][bj][m][n], 0, 0, 0); __builtin_amdgcn_s_setprio(0); } while (0)
#define PG8_WAIT_V(n) asm volatile("s_waitcnt vmcnt(" #n ")" ::: "memory")
#define PG8_WAIT_L(n) asm volatile("s_waitcnt lgkmcnt(" #n ")" ::: "memory")
#define PG8_BAR __builtin_amdgcn_s_barrier()
#define PG8_SCHED __builtin_amdgcn_sched_barrier(0)
    Unit cur, nxt; int ui = 0;
    if (!S.next(0, cur)) return;
    f32x4 acc[2][2][4][2];
#pragma unroll
    for (int a = 0; a < 2; ++a)
#pragma unroll
        for (int b = 0; b < 2; ++b)
#pragma unroll
            for (int m = 0; m < 4; ++m)
#pragma unroll
                for (int n = 0; n < 2; ++n) acc[a][b][m][n] = (f32x4){0.f, 0.f, 0.f, 0.f};
    bf16x8 At[4][2], B0[2][2], B1[2][2];
    const char* cA = (const char*)g.A + (size_t)cur.pm * tstep; const char* cB = (const char*)g.Bt + (size_t)cur.pn * tstep;
    S.a_ready(cur);
    if constexpr (SP2) {
        PG8_STAGE(PG8_SB(0, 0), cB, voffB); PG8_STAGE(PG8_SB(0, 1), cB + hstep, voffB); PG8_STAGE(PG8_SA(0, 0), cA, voffA); PG8_STAGE(PG8_SA(0, 1), cA + hstep, voffA);
        if (wr == 1) PG8_BAR;
        PG8_WAIT_V(2); PG8_BAR;
        PG8_STAGE(PG8_SB(1, 0), cB + kstep, voffB); PG8_STAGE(PG8_SA(1, 0), cA + kstep, voffA); PG8_STAGE(PG8_SB(1, 1), cB + hstep + kstep, voffB);
        PG8_WAIT_V(6); PG8_BAR;
    } else {
        PG8_STAGE(PG8_SB(0, 0), cB, voffB); PG8_STAGE(PG8_SA(0, 0), cA, voffA); PG8_STAGE(PG8_SB(0, 1), cB + hstep, voffB); PG8_STAGE(PG8_SA(0, 1), cA + hstep, voffA);
        if (wr == 1) PG8_BAR;
        PG8_WAIT_V(4); PG8_BAR;
        PG8_STAGE(PG8_SB(1, 0), cB + kstep, voffB); PG8_STAGE(PG8_SA(1, 0), cA + kstep, voffA); PG8_STAGE(PG8_SB(1, 1), cB + hstep + kstep, voffB);
        PG8_WAIT_V(6); PG8_BAR;
    }
    for (;;) {
        const bool has_next = S.next(ui + 1, nxt);
        const char* nA = has_next ? (const char*)g.A + (size_t)nxt.pm * tstep : cA; const char* nB = has_next ? (const char*)g.Bt + (size_t)nxt.pn * tstep : cB;
        for (int t = 0; t < nt; t += 2) {
            const bool last = (t == nt - 2);
            const char* a1 = cA + (size_t)(t + 1) * kstep;
            const char* a2 = last ? nA : cA + (size_t)(t + 2) * kstep; const char* b2 = last ? nB : cB + (size_t)(t + 2) * kstep;
            const char* a3 = a2 + kstep; const char* b3 = b2 + kstep;
            if (last && has_next) S.a_ready(nxt);
            if constexpr (SP2) {
            PG8_LDB(B0, 0, 0); PG8_LDB(B1, 0, 1); PG8_SCHED; PG8_LDA(At, 0, 0); PG8_STAGE(PG8_SA(1, 1), a1 + hstep, voffA);
            PG8_WAIT_V(8); PG8_WAIT_L(0); PG8_BAR; PG8_MMA(0, 0, At, B0); PG8_MMA(0, 1, At, B1); PG8_BAR; PG8_SCHED;
            PG8_LDA(At, 0, 1); PG8_STAGE(PG8_SB(0, 0), b2, voffB); PG8_STAGE(PG8_SB(0, 1), b2 + hstep, voffB); PG8_STAGE(PG8_SA(0, 0), a2, voffA);
            PG8_WAIT_V(8); PG8_WAIT_L(0); PG8_BAR; PG8_MMA(1, 0, At, B0); PG8_MMA(1, 1, At, B1); PG8_BAR; PG8_SCHED;
            PG8_LDB(B0, 1, 0); PG8_LDB(B1, 1, 1); PG8_SCHED; PG8_LDA(At, 1, 0); PG8_STAGE(PG8_SA(0, 1), a2 + hstep, voffA);
            PG8_WAIT_V(8); PG8_WAIT_L(0); PG8_BAR; PG8_MMA(0, 0, At, B0); PG8_MMA(0, 1, At, B1); PG8_BAR; PG8_SCHED;
            PG8_LDA(At, 1, 1); PG8_STAGE(PG8_SB(1, 0), b3, voffB); PG8_STAGE(PG8_SB(1, 1), b3 + hstep, voffB); PG8_STAGE(PG8_SA(1, 0), a3, voffA);
            PG8_WAIT_V(8); PG8_WAIT_L(0); PG8_BAR; PG8_MMA(1, 0, At, B0); PG8_MMA(1, 1, At, B1); PG8_BAR; PG8_SCHED;
            } else {
            PG8_LDB(B0, 0, 0); PG8_SCHED; PG8_LDA(At, 0, 0); PG8_STAGE(PG8_SA(1, 1), a1 + hstep, voffA);
            PG8_WAIT_L(8); PG8_BAR; PG8_WAIT_L(0); PG8_MMA(0, 0, At, B0); PG8_BAR; PG8_SCHED;
            PG8_LDB(B1, 0, 1); PG8_STAGE(PG8_SB(0, 0), b2, voffB);
            PG8_BAR; PG8_WAIT_L(0); PG8_MMA(0, 1, At, B1); PG8_BAR;
            PG8_LDA(At, 0, 1); PG8_STAGE(PG8_SA(0, 0), a2, voffA);
            PG8_BAR; PG8_WAIT_L(0); PG8_MMA(1, 0, At, B0); PG8_BAR; PG8_SCHED;
            PG8_STAGE(PG8_SB(0, 1), b2 + hstep, voffB);
            PG8_WAIT_V(6); PG8_BAR; PG8_MMA(1, 1, At, B1); PG8_BAR;
            PG8_LDB(B0, 1, 0); PG8_SCHED; PG8_LDA(At, 1, 0); PG8_STAGE(PG8_SA(0, 1), a2 + hstep, voffA);
            PG8_WAIT_L(8); PG8_BAR; PG8_WAIT_L(0); PG8_MMA(0, 0, At, B0); PG8_BAR; PG8_SCHED;
            PG8_LDB(B1, 1, 1); PG8_STAGE(PG8_SB(1, 0), b3, voffB);
            PG8_BAR; PG8_WAIT_L(0); PG8_MMA(0, 1, At, B1); PG8_BAR;
            PG8_LDA(At, 1, 1); PG8_STAGE(PG8_SA(1, 0), a3, voffA);
            PG8_BAR; PG8_WAIT_L(0); PG8_MMA(1, 0, At, B0); PG8_BAR; PG8_SCHED;
            PG8_STAGE(PG8_SB(1, 1), b3 + hstep, voffB);
            PG8_WAIT_V(6); PG8_BAR; PG8_MMA(1, 1, At, B1); PG8_BAR;
            }
        }
        if constexpr (ALIGN_EPI) { if (wr == 0) PG8_BAR; }
        if constexpr (!Epi::AFTER_DRAIN) { E(acc, cur, wr, wc, fr, fq); S.done(cur); }
        if (!has_next) break;
#pragma unroll
        for (int a = 0; a < 2; ++a)
#pragma unroll
            for (int b = 0; b < 2; ++b)
#pragma unroll
                for (int m = 0; m < 4; ++m)
#pragma unroll
                    for (int n = 0; n < 2; ++n) acc[a][b][m][n] = (f32x4){0.f, 0.f, 0.f, 0.f};
        cur = nxt; cA = nA; cB = nB; ++ui;
        if constexpr (ALIGN_EPI) { if (wr == 1) PG8_BAR; }
    }
    PG8_WAIT_V(0);
    if constexpr (!ALIGN_EPI) { if (wr == 0) PG8_BAR; }
    PG8_BAR;
    if constexpr (Epi::AFTER_DRAIN) { E.fused(acc, cur, wr, wc, fr, fq, lds, wid, lane); S.done(cur); }
#undef PG8_SA
#undef PG8_SB
#undef PG8_STAGE
#undef PG8_LDA
#undef PG8_LDB
#undef PG8_MMA
#undef PG8_WAIT_V
#undef PG8_WAIT_L
#undef PG8_BAR
#undef PG8_SCHED
}
}
#define LAS __attribute__((address_space(3)))
typedef unsigned short bf16_t;
typedef short bf16x8 __attribute__((ext_vector_type(8)));
typedef float f32x4 __attribute__((ext_vector_type(4)));
typedef unsigned u32x4 __attribute__((ext_vector_type(4)));
typedef unsigned u32x2 __attribute__((ext_vector_type(2)));
typedef LAS unsigned char* ldsp;

constexpr int BATCH = 2, SEQ = 8192, DM = 1024, MROWS = BATCH * SEQ, NH = 8, HD = 64, RWW = 512;
constexpr int NPC = 4352;
constexpr int PC_R = 0, PC_K = 512, PC_V = 1024, PC_ZW = 1536, PC_ZA = 1600, PC_G = 1664, PC_PAD = 2176, PC_SQ = 2304, PC_SK = 2816, PC_SV = 3328, PC_SG = 3840;
constexpr int IN_COLS = 4224, SHIFT_COLS = 1664, NCHUNK = SEQ / 64;
constexpr size_t MiB = 1u << 20;
constexpr size_t WS_MODP = 0, WS_GATE = 786432, WS_W2T = 1 * MiB, WS_A2T = WS_W2T + 131072, WS_WIN = 2 * MiB, WS_WOUT = 19 * MiB, WS_GAM = 23 * MiB,
                 WS_H = 24 * MiB, WS_P = 56 * MiB, WS_D = 192 * MiB, WS_END = 256 * MiB;
constexpr int LDS_BYTES = 159744;
constexpr int NPHASE = 14;

struct Args { const float* in[19]; float* out; unsigned char* ws; int ph_lo, ph_hi; };

__device__ __forceinline__ unsigned f2bf(float f) { unsigned u = __builtin_bit_cast(unsigned, f); return (u + 0x7fffu + ((u >> 16) & 1u)) >> 16; }
__device__ __forceinline__ float bf2f(unsigned u) { return __builtin_bit_cast(float, u << 16); }
__device__ __forceinline__ unsigned pk2(float lo, float hi) { return pg8::cvt_pk_bf16(lo, hi); }
__device__ __forceinline__ f32x4 mfma16(bf16x8 a, bf16x8 b, f32x4 c) { return __builtin_amdgcn_mfma_f32_16x16x32_bf16(a, b, c, 0, 0, 0); }
__device__ __forceinline__ void unpack8(u32x4 w, float* o) {
    o[0] = bf2f(w.x & 0xffffu); o[1] = __builtin_bit_cast(float, w.x & 0xffff0000u); o[2] = bf2f(w.y & 0xffffu); o[3] = __builtin_bit_cast(float, w.y & 0xffff0000u);
    o[4] = bf2f(w.z & 0xffffu); o[5] = __builtin_bit_cast(float, w.z & 0xffff0000u); o[6] = bf2f(w.w & 0xffffu); o[7] = __builtin_bit_cast(float, w.w & 0xffff0000u); }
__device__ __forceinline__ f32x4 unpack4(u32x2 w) { f32x4 o; o[0] = bf2f(w.x & 0xffffu); o[1] = __builtin_bit_cast(float, w.x & 0xffff0000u); o[2] = bf2f(w.y & 0xffffu); o[3] = __builtin_bit_cast(float, w.y & 0xffff0000u); return o; }
__device__ __forceinline__ u32x2 pack4(f32x4 v) { u32x2 w; w.x = pk2(v[0], v[1]); w.y = pk2(v[2], v[3]); return w; }
__device__ __forceinline__ bf16x8 pack8(f32x4 a, f32x4 b) { u32x4 w; w.x = pk2(a[0], a[1]); w.y = pk2(a[2], a[3]); w.z = pk2(b[0], b[1]); w.w = pk2(b[2], b[3]); return __builtin_bit_cast(bf16x8, w); }
__device__ __forceinline__ float wave_sum(float v) {
#pragma unroll
    for (int o = 1; o < 64; o <<= 1) v += __shfl_xor(v, o);
    return v; }
#define WG_BAR() do { asm volatile("s_waitcnt vmcnt(0) lgkmcnt(0)" ::: "memory"); __builtin_amdgcn_s_barrier(); asm volatile("" ::: "memory"); } while (0)
#define LDS_BAR() do { asm volatile("s_waitcnt lgkmcnt(0)" ::: "memory"); __builtin_amdgcn_s_barrier(); asm volatile("" ::: "memory"); } while (0)
__device__ __forceinline__ f32x4 tile64(ldsp A, int arow, ldsp B, int brow, int q, f32x4 acc) {
#pragma unroll
    for (int ks = 0; ks < 2; ++ks) { const bf16x8 a = *(LAS const bf16x8*)(A + arow * 144 + ks * 64 + q * 16), b = *(LAS const bf16x8*)(B + brow * 144 + ks * 64 + q * 16); acc = mfma16(a, b, acc); }
    return acc; }

__device__ __forceinline__ void p0_transpose_item(const float* W, int K, int N, int src_n0, bf16_t* WT, int dst_n0, int k0, LAS float* scr, int lane) {
#pragma unroll 8
    for (int i = 0; i < 32; ++i) { const int kk = 2 * i + (lane >> 5); scr[kk * 33 + (lane & 31)] = src_n0 >= 0 ? W[(size_t)(k0 + kk) * N + src_n0 + (lane & 31)] : 0.f; }
    asm volatile("s_waitcnt lgkmcnt(0)" ::: "memory");
    const int c = lane & 7;
#pragma unroll
    for (int j = 0; j < 4; ++j) { const int n = (lane >> 3) + 8 * j; const LAS float* s = scr + (8 * c) * 33 + n;
        u32x4 o; o.x = pk2(s[0 * 33], s[1 * 33]); o.y = pk2(s[2 * 33], s[3 * 33]); o.z = pk2(s[4 * 33], s[5 * 33]); o.w = pk2(s[6 * 33], s[7 * 33]);
        *(u32x4*)(WT + (size_t)(dst_n0 + n) * K + k0 + 8 * c) = o; }
    asm volatile("s_waitcnt lgkmcnt(0)" ::: "memory");
}
__device__ __forceinline__ void phase_p0(const Args& a, ldsp lds, int tid, int lane, int wave, int G) {
    unsigned char* ws = a.ws;
    LAS float* scr = (LAS float*)(lds + wave * 16384);
    const int gw = blockIdx.x * 8 + wave, NGW = G * 8;
    constexpr int I_IN = 16 * (NPC / 32), I_OUT = 16 * (DM / 32), NITEMS = 2 * I_IN + 2 * I_OUT;
    for (int it = gw; it < NITEMS; it += NGW) {
        int r = it;
        if (r < 2 * I_IN) { const int l = r / I_IN; r -= l * I_IN; const int kb = r / (NPC / 32), nb = r % (NPC / 32); const int dn = 32 * nb;
            const int sn = dn < PC_PAD ? dn : (dn < PC_SQ ? -1 : dn - 128);
            p0_transpose_item(a.in[5] + (size_t)l * DM * IN_COLS, DM, IN_COLS, sn, (bf16_t*)(ws + WS_WIN) + (size_t)l * NPC * DM, dn, 64 * kb, scr, lane); }
        else { r -= 2 * I_IN; const int l = r / I_OUT; r -= l * I_OUT; const int kb = r / (DM / 32), nb = r % (DM / 32);
            p0_transpose_item(a.in[6] + (size_t)l * DM * DM, DM, DM, 32 * nb, (bf16_t*)(ws + WS_WOUT) + (size_t)l * DM * DM, 32 * nb, 64 * kb, scr, lane); }
    }
    { const int gt = blockIdx.x * 512 + tid, NT = G * 512;
      for (int o = gt; o < 2 * 65536; o += NT) { const int which = o >> 16, rem = o & 65535, l = rem >> 15, r2 = rem & 32767, n = r2 >> 6, m = r2 & 63;
          const float v = a.in[which ? 11 : 9][(size_t)(l * 64 + m) * 512 + n];
          ((bf16_t*)(ws + (which ? WS_A2T : WS_W2T)))[rem] = (bf16_t)f2bf(v); } }
    WG_BAR();
    LAS float* red = (LAS float*)lds;
    for (int unit = blockIdx.x; unit < 384; unit += G) {
        const int l = unit / 192, r = unit % 192, kp = r / 12, ncb = r % 12;
        const int n = ncb * 256 + (tid & 255), kh = tid >> 8, kbeg = kp * 64 + kh * 32;
        const float* W = a.in[3] + (size_t)l * DM * 3072 + n; const float* c0 = a.in[1]; const float* c1 = a.in[1] + DM;
        float a0 = 0.f, a1 = 0.f;
#pragma unroll 8
        for (int k = kbeg; k < kbeg + 32; ++k) { const float w = W[(size_t)k * 3072]; const float x0 = c0[k], x1 = c1[k];
            a0 += x0 / (1.f + __expf(-x0)) * w; a1 += x1 / (1.f + __expf(-x1)) * w; }
        if (kh == 1) { red[tid & 255] = a0; red[256 + (tid & 255)] = a1; }
        LDS_BAR();
        if (kh == 0) { float* mp = (float*)(ws + WS_MODP) + (size_t)((l * 16 + kp) * 2) * 3072 + n; mp[0] = a0 + red[tid]; mp[3072] = a1 + red[256 + tid]; }
        LDS_BAR();
    }
}

__device__ __forceinline__ void phase_h(const Args& a, ldsp lds, int l, const float* xin, int tid, int lane, int wave, int G) {
    unsigned char* ws = a.ws;
    LAS float* sc = (LAS float*)lds; LAS float* sh = sc + 2048;
    const float* modp = (const float*)(ws + WS_MODP) + (size_t)l * 16 * 2 * 3072; const float* adab = a.in[4] + l * 3072; const float* ng = a.in[2] + l * DM;
    for (int idx = tid; idx < 2048; idx += 512) { const int b = idx >> 10, k = idx & 1023; float s0 = adab[k], s1 = adab[1024 + k], s2 = adab[2048 + k];
        for (int kp = 0; kp < 16; ++kp) { const float* mp = modp + (size_t)(kp * 2 + b) * 3072; s0 += mp[k]; s1 += mp[1024 + k]; s2 += mp[2048 + k]; }
        sh[idx] = s0; sc[idx] = ng[k] * (1.f + s1);
        if (blockIdx.x == 0) ((float*)(ws + WS_GATE))[(l * 2 + b) * 1024 + k] = s2; }
    LDS_BAR();
    bf16_t* H = (bf16_t*)(ws + WS_H);
    const int gw = blockIdx.x * 8 + wave, NGW = G * 8;
    for (int m = gw; m < MROWS; m += NGW) {
        const f32x4* xr = (const f32x4*)(xin + (size_t)m * DM) + lane; const int b = m >> 13;
        f32x4 v[4]; float s = 0.f;
#pragma unroll
        for (int j = 0; j < 4; ++j) { v[j] = xr[64 * j]; s += (v[j][0] * v[j][0] + v[j][1] * v[j][1]) + (v[j][2] * v[j][2] + v[j][3] * v[j][3]); }
        const float rstd = 1.0f / sqrtf(wave_sum(s) * (1.f / DM) + 1e-6f);
        unsigned long long* o8 = (unsigned long long*)(H + (size_t)m * DM) + lane;
#pragma unroll
        for (int j = 0; j < 4; ++j) { const int k = 4 * lane + 256 * j; const f32x4 scv = *(LAS const f32x4*)(sc + b * 1024 + k), shv = *(LAS const f32x4*)(sh + b * 1024 + k);
            const f32x4 hv = v[j] * rstd * scv + shv; o8[64 * j] = (unsigned long long)pk2(hv[0], hv[1]) | ((unsigned long long)pk2(hv[2], hv[3]) << 32); }
    }
}
constexpr int L_RS = 0, L_KS = 16384, L_PB = 0, L_PTB = 9216, L_TB = 18432, L_TZW = 32768, L_ZA = 32768 + 9216, L_XT = 32768, L_C = 32768 + 18432;
constexpr int L_AG = L_C, L_RG = L_C + 9216, L_BG = L_C + 2 * 9216, L_KG = L_C + 3 * 9216, L_AGT = L_C + 4 * 9216, L_BTT = L_C + 5 * 9216, L_KTT = L_C + 6 * 9216, L_VT = L_C + 7 * 9216;
constexpr int L_D = L_C + 8 * 9216, L_AAK = L_D, L_ARB = L_D + 9216, L_ARK = L_D + 2 * 9216, L_MISC = L_D + 3 * 9216, L_AKVT = L_BG;
static_assert(L_MISC + 2048 <= LDS_BYTES, "R1 LDS map");
__device__ __forceinline__ float tanh_f(float x) { return 1.f - 2.f / (__expf(2.f * x) + 1.f); }
__device__ __forceinline__ void st16(ldsp p, float v) { *(LAS bf16_t*)p = (bf16_t)f2bf(v); }

#ifdef DBG_CHECK
constexpr size_t WS_DBG = 23 * MiB + 512 * 1024;
constexpr size_t WS_DUMP = WS_DBG + 256 * 1024;
__device__ __forceinline__ void dbg_dump(unsigned char* ws, ldsp lds, int l, int u, int tid, int ldsoff, int bytes, int dstoff) {
    if (l == 0 && u == 0) { for (int i = tid * 4; i < bytes; i += 2048) *(unsigned*)(ws + WS_DUMP + dstoff + i) = *(LAS const unsigned*)(lds + ldsoff + i); }
}
#define DBG_DUMP(ldsoff, bytes, dstoff) dbg_dump(ws, lds, l, u, tid, ldsoff, bytes, dstoff)
#else
#define DBG_DUMP(ldsoff, bytes, dstoff) do { } while (0)
#endif
__device__ __forceinline__ void r1_unit(const Args& a, ldsp lds, int l, int u, int tid, int lane, int wave) {
    unsigned char* ws = a.ws;
    const int b = u >> 10, h = (u >> 7) & 7, c = u & 127, row0 = b * SEQ + c * 64, l15 = lane & 15, q = lane >> 4;
    bf16_t* P = (bf16_t*)(ws + WS_P);
    LAS float* RS = (LAS float*)(lds + L_RS); LAS float* KS = (LAS float*)(lds + L_KS);
    LAS float* rnorm = (LAS float*)(lds + L_MISC); LAS float* bonp = rnorm + 64;
    {
        const int tt = tid >> 3, part = tid & 7; const int row = row0 + tt; const bool hasprev = !(c == 0 && tt == 0);
        const bf16_t* prow = P + (size_t)row * NPC; const bf16_t* pprev = prow - NPC; const float* mu = a.in[7] + l * SHIFT_COLS;
        float cur[8], prv[8], ps[8];
#define R1_SHIFT(col) do { unpack8(*(const u32x4*)(prow + (col)), cur); if (hasprev) unpack8(*(const u32x4*)(pprev + (col)), prv); else { _Pragma("unroll") for (int e = 0; e < 8; ++e) prv[e] = 0.f; } \
        const f32x4 m0 = *(const f32x4*)(mu + (col)), m1 = *(const f32x4*)(mu + (col) + 4); \
        _Pragma("unroll") for (int e = 0; e < 4; ++e) { ps[e] = cur[e] + (prv[e] - cur[e]) * m0[e]; ps[4 + e] = cur[4 + e] + (prv[4 + e] - cur[4 + e]) * m1[e]; } } while (0)
        R1_SHIFT(PC_R + h * 64 + part * 8);
        *(LAS f32x4*)(RS + tt * 64 + part * 8) = (f32x4){ps[0], ps[1], ps[2], ps[3]}; *(LAS f32x4*)(RS + tt * 64 + part * 8 + 4) = (f32x4){ps[4], ps[5], ps[6], ps[7]};
        R1_SHIFT(PC_K + h * 64 + part * 8);
        *(LAS f32x4*)(KS + tt * 64 + part * 8) = (f32x4){ps[0], ps[1], ps[2], ps[3]}; *(LAS f32x4*)(KS + tt * 64 + part * 8 + 4) = (f32x4){ps[4], ps[5], ps[6], ps[7]};
        { const float* kkp = a.in[12] + l * RWW + h * 64 + part * 8; float ss = 0.f;
#pragma unroll
          for (int e = 0; e < 8; ++e) { const float t = ps[e] * kkp[e]; ss += t * t; }
          ss += __shfl_xor(ss, 1); ss += __shfl_xor(ss, 2); ss += __shfl_xor(ss, 4);
          if (part == 0) rnorm[tt] = 1.0f / sqrtf(fmaxf(ss, 1e-24f)); }
        R1_SHIFT(PC_V + h * 64 + part * 8);
#pragma unroll
        for (int e = 0; e < 8; ++e) st16(lds + L_VT + (part * 8 + e) * 144 + tt * 2, ps[e]);
        R1_SHIFT(PC_ZW + part * 8);
        { u32x4 w; w.x = pk2(tanh_f(ps[0]), tanh_f(ps[1])); w.y = pk2(tanh_f(ps[2]), tanh_f(ps[3])); w.z = pk2(tanh_f(ps[4]), tanh_f(ps[5])); w.w = pk2(tanh_f(ps[6]), tanh_f(ps[7]));
          *(LAS u32x4*)(lds + L_TZW + tt * 144 + part * 16) = w; }
        R1_SHIFT(PC_ZA + part * 8);
        { u32x4 w; w.x = pk2(ps[0], ps[1]); w.y = pk2(ps[2], ps[3]); w.z = pk2(ps[4], ps[5]); w.w = pk2(ps[6], ps[7]); *(LAS u32x4*)(lds + L_ZA + tt * 144 + part * 16) = w; }
#undef R1_SHIFT
    }
    LDS_BAR();
    if (wave < 4) {
        const int jl = 16 * wave + l15, jg = h * 64 + jl;
        f32x4 wacc[4], aacc[4];
        { const bf16_t* w2t = (const bf16_t*)(ws + WS_W2T) + ((size_t)l * 512 + jg) * 64; const bf16_t* a2t = (const bf16_t*)(ws + WS_A2T) + ((size_t)l * 512 + jg) * 64;
          bf16x8 bw[2], ba[2];
#pragma unroll
          for (int ks = 0; ks < 2; ++ks) { bw[ks] = *(const bf16x8*)(w2t + 32 * ks + 8 * q); ba[ks] = *(const bf16x8*)(a2t + 32 * ks + 8 * q); }
#pragma unroll
          for (int mt = 0; mt < 4; ++mt) { wacc[mt] = (f32x4){0.f, 0.f, 0.f, 0.f}; aacc[mt] = (f32x4){0.f, 0.f, 0.f, 0.f};
#pragma unroll
              for (int ks = 0; ks < 2; ++ks) { const bf16x8 a1 = *(LAS const bf16x8*)(lds + L_TZW + (16 * mt + l15) * 144 + ks * 64 + q * 16), a2 = *(LAS const bf16x8*)(lds + L_ZA + (16 * mt + l15) * 144 + ks * 64 + q * 16);
                  wacc[mt] = mfma16(a1, bw[ks], wacc[mt]); aacc[mt] = mfma16(a2, ba[ks], aacc[mt]); } } }
        const float w0v = a.in[8][l * RWW + jg], a0v = a.in[10][l * RWW + jg], kkv = a.in[12][l * RWW + jg], kav = a.in[13][l * RWW + jg], rkv = a.in[14][l * RWW + jg];
        f32x4 ldv[4], cin[4]; float carry = 0.f;
#pragma unroll
        for (int mt = 0; mt < 4; ++mt) {
#pragma unroll
            for (int r = 0; r < 4; ++r) { const float wa = w0v + wacc[mt][r]; const float sp = fmaxf(-wa, 0.f) + __logf(1.f + __expf(-fabsf(wa)));
                ldv[mt][r] = -__expf(-sp - 0.5f);
                aacc[mt][r] = 1.f / (1.f + __expf(-(a0v + aacc[mt][r]))); }
            const float p0 = ldv[mt][0], p1 = p0 + ldv[mt][1], p2 = p1 + ldv[mt][2], p3 = p2 + ldv[mt][3];
            const float t0 = __shfl(p3, l15), t1 = __shfl(p3, l15 + 16), t2 = __shfl(p3, l15 + 32), t3 = __shfl(p3, l15 + 48);
            const float base = carry + (q > 0 ? t0 : 0.f) + (q > 1 ? t1 : 0.f) + (q > 2 ? t2 : 0.f);
            cin[mt] = (f32x4){base + p0, base + p1, base + p2, base + p3}; carry += (t0 + t1) + (t2 + t3);
        }
        const float ctot = carry;
#pragma unroll
        for (int mt = 0; mt < 4; ++mt) { f32x4 agt, btt, ktt;
#pragma unroll
            for (int r = 0; r < 4; ++r) { const int t = 16 * mt + 4 * q + r; const float rr = RS[t * 64 + jl], kr = KS[t * 64 + jl], rn = rnorm[t];
                const float kk = kr * kkv * rn, av = aacc[mt][r], bq = kk * av, kp = kr * (1.f + (av - 1.f) * kav);
                const float ci = cin[mt][r], e_in = __expf(ci), e_ex = __expf(ci - ldv[mt][r]), e_ni = __expf(-ci), e_t = __expf(ctot - ci);
                const float Ag = -kk * e_ex, Rg = rr * e_in, Bg = bq * e_ni, Kg = kp * e_ni; agt[r] = Ag; btt[r] = bq * e_t; ktt[r] = kp * e_t;
                st16(lds + L_AG + t * 144 + jl * 2, Ag); st16(lds + L_RG + t * 144 + jl * 2, Rg); st16(lds + L_BG + t * 144 + jl * 2, Bg); st16(lds + L_KG + t * 144 + jl * 2, Kg);
                float bon = rr * kp * rkv; bon += __shfl_xor(bon, 1); bon += __shfl_xor(bon, 2); bon += __shfl_xor(bon, 4); bon += __shfl_xor(bon, 8);
                if (l15 == 0) bonp[wave * 64 + t] = bon; }
            *(LAS u32x2*)(lds + L_AGT + jl * 144 + (16 * mt + 4 * q) * 2) = pack4(agt); *(LAS u32x2*)(lds + L_BTT + jl * 144 + (16 * mt + 4 * q) * 2) = pack4(btt);
            *(LAS u32x2*)(lds + L_KTT + jl * 144 + (16 * mt + 4 * q) * 2) = pack4(ktt); }
        if (q == 0) ((float*)(ws + WS_GAM))[(size_t)u * 64 + jl] = __expf(ctot);
    }
    LDS_BAR();
    DBG_DUMP(L_C, 73728, 0);
    if (tid < 64) { const float bs = (bonp[tid] + bonp[64 + tid]) + (bonp[128 + tid] + bonp[192 + tid]); *(float*)((unsigned char*)(P + (size_t)(row0 + tid) * NPC + PC_PAD) + h * 4) = bs; }
    { const int blk = wave & 3, half = wave >> 2; const int aoff = (blk & 1) ? L_KG : L_BG, boff = (blk & 2) ? L_RG : L_AG;
      const int dest = blk == 0 ? L_PB : (blk == 1 ? L_AAK : (blk == 2 ? L_ARB : L_ARK));
#pragma unroll 1
      for (int i = 0; i < 8; ++i) { const int ti = 2 * i + half, mt = ti >> 2, nt = ti & 3; f32x4 acc = (f32x4){0.f, 0.f, 0.f, 0.f};
          if (mt <= nt) acc = tile64(lds + aoff, 16 * mt + l15, lds + boff, 16 * nt + l15, q, acc);
          const int t = 16 * nt + l15, tb = 16 * mt + 4 * q;
#pragma unroll
          for (int r = 0; r < 4; ++r) { const bool keep = (blk < 2) ? (tb + r < t) : (tb + r <= t); acc[r] = keep ? acc[r] : 0.f; }
          *(LAS u32x2*)(lds + dest + t * 144 + tb * 2) = pack4(acc);
          if (blk == 0) {
#pragma unroll
              for (int r = 0; r < 4; ++r) st16(lds + L_PTB + (tb + r) * 144 + t * 2, acc[r]); } } }
    LDS_BAR();
    DBG_DUMP(L_PB, 18432, 73728); DBG_DUMP(L_D, 27648, 73728 + 18432);
#pragma unroll
    for (int i = 0; i < 2; ++i) { const int id = wave * 2 + i, mt = id >> 2, nt = id & 3; f32x4 acc = (f32x4){0.f, 0.f, 0.f, 0.f};
        acc = tile64(lds + L_AAK, 16 * mt + l15, lds + L_VT, 16 * nt + l15, q, acc);
        *(LAS u32x2*)(lds + L_AKVT + (16 * nt + l15) * 144 + (16 * mt + 4 * q) * 2) = pack4(acc); }
#ifdef DBG_CHECK
    LDS_BAR(); DBG_DUMP(L_AKVT, 9216, -49152); LDS_BAR();
#endif
    { const int mt = wave >> 1; f32x4 Tacc[2], Pn[2];
#pragma unroll
      for (int i = 0; i < 2; ++i) { const int nt = 2 * (wave & 1) + i, tau = 16 * nt + l15;
#pragma unroll
          for (int r = 0; r < 4; ++r) { const int t = 16 * mt + 4 * q + r; Tacc[i][r] = bf2f(*(LAS const bf16_t*)(lds + L_PB + t * 144 + tau * 2)) + (t == tau ? 1.f : 0.f); } }
      for (int round = 0; round < 5; ++round) {
#pragma unroll
          for (int i = 0; i < 2; ++i) { const int nt = 2 * (wave & 1) + i; Pn[i] = (f32x4){0.f, 0.f, 0.f, 0.f};
              if (nt <= mt) Pn[i] = tile64(lds + L_PB, 16 * mt + l15, lds + L_PTB, 16 * nt + l15, q, Pn[i]); }
          LDS_BAR();
#pragma unroll
          for (int i = 0; i < 2; ++i) { const int nt = 2 * (wave & 1) + i, tau = 16 * nt + l15;
#pragma unroll
              for (int r = 0; r < 4; ++r) { const int t = 16 * mt + 4 * q + r; st16(lds + L_PB + t * 144 + tau * 2, Pn[i][r]); st16(lds + L_TB + t * 144 + tau * 2, Tacc[i][r]); }
              *(LAS u32x2*)(lds + L_PTB + tau * 144 + (16 * mt + 4 * q) * 2) = pack4(Pn[i]); }
          LDS_BAR();
#pragma unroll
          for (int i = 0; i < 2; ++i) { const int nt = 2 * (wave & 1) + i; if (nt <= mt) Tacc[i] = tile64(lds + L_TB, 16 * mt + l15, lds + L_PTB, 16 * nt + l15, q, Tacc[i]); }
      }
      LDS_BAR();
#pragma unroll
      for (int i = 0; i < 2; ++i) { const int nt = 2 * (wave & 1) + i, tau = 16 * nt + l15;
#pragma unroll
          for (int r = 0; r < 4; ++r) { const int t = 16 * mt + 4 * q + r; st16(lds + L_TB + t * 144 + tau * 2, Tacc[i][r]); } }
    }
    LDS_BAR();
    DBG_DUMP(L_TB, 9216, 119808); DBG_DUMP(L_AKVT, 9216, 129024);
#pragma unroll 1
    for (int i = 0; i < 4; ++i) { const int id = wave * 4 + i, mt = id & 3, nt = id >> 2; f32x4 acc = (f32x4){0.f, 0.f, 0.f, 0.f};
        acc = tile64(lds + L_TB, 16 * mt + l15, nt < 4 ? lds + L_AGT : lds + L_AKVT, 16 * (nt & 3) + l15, q, acc);
        *(LAS u32x2*)(lds + L_XT + (16 * nt + l15) * 144 + (16 * mt + 4 * q) * 2) = pack4(acc); }
    LDS_BAR();
    DBG_DUMP(L_XT, 18432, 138240);
    { unsigned char* Du = ws + WS_D + (size_t)u * 32768; const int kind = wave >> 1;
#pragma unroll 1
      for (int i = 0; i < 8; ++i) { const int id = (wave & 1) * 8 + i, mt = id & 3, nt = id >> 2; f32x4 acc = (f32x4){0.f, 0.f, 0.f, 0.f}; const int row = 16 * nt + l15;
          if (kind == 0) { acc = tile64(lds + L_XT, 16 * mt + l15, lds + L_BTT, row, q, acc); }
          else if (kind == 1) { acc = tile64(lds + L_XT, 16 * mt + l15, lds + L_ARB, row, q, acc); acc += unpack4(*(LAS const u32x2*)(lds + L_RG + row * 144 + (16 * mt + 4 * q) * 2)); }
          else if (kind == 2) { acc = tile64(lds + L_BTT, 16 * mt + l15, lds + L_XT, 64 + row, q, acc); acc = tile64(lds + L_KTT, 16 * mt + l15, lds + L_VT, row, q, acc); }
          else { acc = tile64(lds + L_ARB, 16 * mt + l15, lds + L_XT, 64 + row, q, acc); acc = tile64(lds + L_ARK, 16 * mt + l15, lds + L_VT, row, q, acc); }
          const int sw = (row >> 1) & 7;
          const int off = kind < 2 ? row * 128 + (((4 * (mt >> 1) + q) ^ sw) * 16) + 8 * (mt & 1) : row * 128 + (((2 * mt + (q >> 1)) ^ sw) * 16) + 8 * (q & 1);
          *(u32x2*)(Du + kind * 8192 + off) = pack4(acc); } }
    LDS_BAR();
}

__device__ __forceinline__ void sb_task(const Args& a, ldsp vs, int l, int task, int lane) {
    unsigned char* ws = a.ws; const bf16_t* P = (const bf16_t*)(ws + WS_P); bf16_t* Y = (bf16_t*)(ws + WS_H);
    const int bh = task >> 9, qt = task & 511, b = bh >> 3, h = bh & 7, q0 = qt * 16, rowb = b * SEQ, l15 = lane & 15, q = lane >> 4;
    bf16x8 bq[2];
#pragma unroll
    for (int ks = 0; ks < 2; ++ks) bq[ks] = *(const bf16x8*)(P + (size_t)(rowb + q0 + l15) * NPC + PC_SQ + h * 64 + 32 * ks + 8 * q);
    bf16x8 am[2];
#pragma unroll
    for (int mt = 0; mt < 2; ++mt)
#pragma unroll
        for (int e = 0; e < 8; ++e) am[mt][e] = ((16 * (e >> 2) + 4 * q + (e & 3)) > (16 * mt + l15)) ? (short)0x3F80 : (short)0;
    f32x4 O[4];
#pragma unroll
    for (int nt = 0; nt < 4; ++nt) O[nt] = (f32x4){0.f, 0.f, 0.f, 0.f};
    float carry = 0.f; const int t = q0 + l15;
    int kb = (q0 + 14) >> 5;
    bf16x8 kA[2][2], kN[2][2]; u32x4 vR[4], vN[4];
#define SB_LOAD(KA, VR, kbv) do { _Pragma("unroll") for (int mt = 0; mt < 2; ++mt) _Pragma("unroll") for (int ks = 0; ks < 2; ++ks) \
        KA[mt][ks] = *(const bf16x8*)(P + (size_t)(rowb + 32 * (kbv) + 16 * mt + l15) * NPC + PC_SK + h * 64 + 32 * ks + 8 * q); \
        _Pragma("unroll") for (int i = 0; i < 4; ++i) { const int pi = lane + 64 * i; VR[i] = *(const u32x4*)(P + (size_t)(rowb + 32 * (kbv) + (pi >> 3)) * NPC + PC_SV + h * 64 + (pi & 7) * 8); } } while (0)
    SB_LOAD(kA, vR, kb);
    for (;;) {
#pragma unroll
        for (int i = 0; i < 4; ++i) { const int pi = lane + 64 * i; *(LAS u32x4*)(vs + (pi >> 3) * 144 + (pi & 7) * 16) = vR[i]; }
        if (kb > 0) SB_LOAD(kN, vN, kb - 1);
        f32x4 ell[2], lsz[2]; bool valid[2][4];
#pragma unroll
        for (int mt = 0; mt < 2; ++mt) { f32x4 z = (f32x4){0.f, 0.f, 0.f, 0.f}; z = mfma16(kA[mt][0], bq[0], z); z = mfma16(kA[mt][1], bq[1], z);
#pragma unroll
            for (int r = 0; r < 4; ++r) { const int s = 32 * kb + 16 * mt + 4 * q + r; const float zz = z[r] * 0.125f; const float sp = fmaxf(zz, 0.f) + __logf(1.f + __expf(-fabsf(zz)));
                valid[mt][r] = s < t; ell[mt][r] = valid[mt][r] ? -sp : 0.f; lsz[mt][r] = zz - sp; } }
        const bf16x8 Lhi = pack8(ell[0], ell[1]);
        f32x4 lo0, lo1; { const u32x4 w = __builtin_bit_cast(u32x4, Lhi);
            lo0[0] = ell[0][0] - bf2f(w.x & 0xffffu); lo0[1] = ell[0][1] - __builtin_bit_cast(float, w.x & 0xffff0000u); lo0[2] = ell[0][2] - bf2f(w.y & 0xffffu); lo0[3] = ell[0][3] - __builtin_bit_cast(float, w.y & 0xffff0000u);
            lo1[0] = ell[1][0] - bf2f(w.z & 0xffffu); lo1[1] = ell[1][1] - __builtin_bit_cast(float, w.z & 0xffff0000u); lo1[2] = ell[1][2] - bf2f(w.w & 0xffffu); lo1[3] = ell[1][3] - __builtin_bit_cast(float, w.w & 0xffff0000u); }
        const bf16x8 Llo = pack8(lo0, lo1);
        f32x4 aft[2], wv[2];
#pragma unroll
        for (int mt = 0; mt < 2; ++mt) { aft[mt] = (f32x4){0.f, 0.f, 0.f, 0.f}; aft[mt] = mfma16(am[mt], Lhi, aft[mt]); aft[mt] = mfma16(am[mt], Llo, aft[mt]);
#pragma unroll
            for (int r = 0; r < 4; ++r) wv[mt][r] = valid[mt][r] ? __expf(lsz[mt][r] + aft[mt][r] + carry) : 0.f; }
        carry += __shfl(aft[0][0] + ell[0][0], l15);
        const bf16x8 Wop = pack8(wv[0], wv[1]);
        asm volatile("s_waitcnt lgkmcnt(0)" ::: "memory");
#pragma unroll
        for (int nt = 0; nt < 4; ++nt) { bf16x8 vb;
#pragma unroll
            for (int e = 0; e < 8; ++e) vb[e] = (short)*(LAS const bf16_t*)(vs + (16 * (e >> 2) + 4 * q + (e & 3)) * 144 + (16 * nt + l15) * 2);
            O[nt] = mfma16(Wop, vb, O[nt]); }
        if (kb == 0) break;
        if (__all(carry < -100.f)) break;
        --kb;
#pragma unroll
        for (int mt = 0; mt < 2; ++mt)
#pragma unroll
            for (int ks = 0; ks < 2; ++ks) kA[mt][ks] = kN[mt][ks];
#pragma unroll
        for (int i = 0; i < 4; ++i) vR[i] = vN[i];
    }
#undef SB_LOAD
    const float* sbg = a.in[17] + l * 512 + h * 64;
#pragma unroll
    for (int r = 0; r < 4; ++r) { float ss = (O[0][r] * O[0][r] + O[1][r] * O[1][r]) + (O[2][r] * O[2][r] + O[3][r] * O[3][r]);
        ss += __shfl_xor(ss, 1); ss += __shfl_xor(ss, 2); ss += __shfl_xor(ss, 4); ss += __shfl_xor(ss, 8);
        const float rms = 1.0f / sqrtf(ss * (1.f / 64.f) + 1e-6f); const int tq = q0 + 4 * q + r;
        const size_t row = (size_t)(rowb + ((tq & 127) << 6) + (tq >> 7));
#pragma unroll
        for (int nt = 0; nt < 4; ++nt) { const int d = 16 * nt + l15; const float g = bf2f(P[row * NPC + PC_SG + h * 64 + d]);
            float yv = O[nt][r] * rms * sbg[d] * (g / (1.f + __expf(-g)));
#ifdef DBG_ZERO_SB
            yv = 0.f;
#endif
            Y[row * DM + 512 + h * 64 + d] = (bf16_t)f2bf(yv); } }
}
__device__ __forceinline__ void phase_r2(const Args& a, ldsp lds, int tid, int lane, int wave) {
    if (blockIdx.x >= 16) return;
    unsigned char* ws = a.ws; const int bh = blockIdx.x, b = bh >> 3, h = bh & 7, u0 = bh * NCHUNK, l15 = lane & 15, q = lane >> 4;
    const unsigned char* Dg = ws + WS_D + (size_t)u0 * 32768;
    if (wave >= 4) {
        const int wl = wave - 4;
#define R2_ISSUE(cc) do { const int c_ = (cc) < NCHUNK ? (cc) : NCHUNK - 1; _Pragma("unroll") for (int i = 0; i < 8; ++i) \
        __builtin_amdgcn_global_load_lds((const unsigned*)(Dg + (size_t)c_ * 32768 + (wl * 8 + i) * 1024 + lane * 16), (LAS unsigned*)(lds + ((cc) & 3) * 32768 + (wl * 8 + i) * 1024), 16, 0, 0); } while (0)
        R2_ISSUE(0); R2_ISSUE(1); R2_ISSUE(2);
        asm volatile("s_waitcnt vmcnt(16)" ::: "memory");
        __builtin_amdgcn_s_barrier();
        for (int c = 0; c < NCHUNK; ++c) {
            R2_ISSUE(c + 3);
            asm volatile("s_waitcnt vmcnt(16)" ::: "memory");
            __builtin_amdgcn_s_barrier();
        }
        asm volatile("s_waitcnt vmcnt(0)" ::: "memory");
#undef R2_ISSUE
    } else {
        const int ig = wave, irow = 16 * ig + l15, swi = (irow >> 1) & 7;
        const float* gam = (const float*)(ws + WS_GAM) + (size_t)u0 * 64;
        float* yraw = (float*)(ws + WS_P);
        f32x4 S[4], gcur[4], gnext[4];
#pragma unroll
        for (int mt = 0; mt < 4; ++mt) { S[mt] = (f32x4){0.f, 0.f, 0.f, 0.f}; gcur[mt] = *(const f32x4*)(gam + 16 * mt + 4 * q); gnext[mt] = gcur[mt]; }
        asm volatile("" ::: "memory");
        __builtin_amdgcn_s_barrier();
        asm volatile("" ::: "memory");
        for (int c = 0; c < NCHUNK; ++c) {
            ldsp slot = lds + (c & 3) * 32768;
            if (c + 1 < NCHUNK) {
#pragma unroll
                for (int mt = 0; mt < 4; ++mt) gnext[mt] = *(const f32x4*)(gam + (size_t)(c + 1) * 64 + 16 * mt + 4 * q); }
            bf16x8 sb[2]; sb[0] = pack8(S[0], S[1]); sb[1] = pack8(S[2], S[3]);
            f32x4 aS[4], aY[4];
#pragma unroll
            for (int mt = 0; mt < 4; ++mt) { const int po = irow * 128 + (((2 * mt + (q >> 1)) ^ swi) * 16) + 8 * (q & 1);
                aS[mt] = gcur[mt] * S[mt] + unpack4(*(LAS const u32x2*)(slot + 16384 + po)); aY[mt] = unpack4(*(LAS const u32x2*)(slot + 24576 + po)); }
#pragma unroll
            for (int ks = 0; ks < 2; ++ks)
#pragma unroll
                for (int mt = 0; mt < 4; ++mt) { const int jr = 16 * mt + l15; const bf16x8 pa = *(LAS const bf16x8*)(slot + jr * 128 + (((4 * ks + q) ^ ((jr >> 1) & 7)) * 16)); aS[mt] = mfma16(pa, sb[ks], aS[mt]); }
#pragma unroll
            for (int ks = 0; ks < 2; ++ks)
#pragma unroll
                for (int mt = 0; mt < 4; ++mt) { const int jr = 16 * mt + l15; const bf16x8 ra = *(LAS const bf16x8*)(slot + 8192 + jr * 128 + (((4 * ks + q) ^ ((jr >> 1) & 7)) * 16)); aY[mt] = mfma16(ra, sb[ks], aY[mt]); }
#pragma unroll
            for (int mt = 0; mt < 4; ++mt) { S[mt] = aS[mt]; gcur[mt] = gnext[mt];
#pragma unroll
                for (int r = 0; r < 4; ++r) { const size_t row = (size_t)(b * SEQ + c * 64 + 16 * mt + 4 * q + r); *(float*)((unsigned char*)yraw + row * (NPC * 2) + (h * 64 + irow) * 4) = aY[mt][r]; } }
            asm volatile("s_waitcnt lgkmcnt(0)" ::: "memory");
            __builtin_amdgcn_s_barrier();
            asm volatile("" ::: "memory");
        }
    }
    WG_BAR();
}

__device__ __forceinline__ void phase_r3(const Args& a, int l, int lane, int wave, int G) {
    unsigned char* ws = a.ws; const bf16_t* P = (const bf16_t*)(ws + WS_P); bf16_t* Y = (bf16_t*)(ws + WS_H);
    const int gw = blockIdx.x * 8 + wave, NGW = G * 8, c0 = 8 * lane, h = lane >> 3;
    const float* lnw = a.in[15] + l * RWW + c0; const float* lnb = a.in[16] + l * RWW + c0; const float* mu = a.in[7] + l * SHIFT_COLS + PC_V + c0;
    const f32x4 w0 = *(const f32x4*)lnw, w1 = *(const f32x4*)(lnw + 4), b0 = *(const f32x4*)lnb, b1 = *(const f32x4*)(lnb + 4), m0 = *(const f32x4*)mu, m1 = *(const f32x4*)(mu + 4);
    for (int m = gw; m < MROWS; m += NGW) {
        const unsigned char* prow = (const unsigned char*)(P + (size_t)m * NPC);
        const f32x4 y0 = *(const f32x4*)(prow + c0 * 4), y1 = *(const f32x4*)(prow + c0 * 4 + 16);
        float s = (y0[0] + y0[1]) + (y0[2] + y0[3]) + (y1[0] + y1[1]) + (y1[2] + y1[3]);
        s += __shfl_xor(s, 1); s += __shfl_xor(s, 2); s += __shfl_xor(s, 4);
        const float mean = s * (1.f / 64.f); const f32x4 d0 = y0 - mean, d1 = y1 - mean;
        float v = (d0[0] * d0[0] + d0[1] * d0[1]) + (d0[2] * d0[2] + d0[3] * d0[3]) + (d1[0] * d1[0] + d1[1] * d1[1]) + (d1[2] * d1[2] + d1[3] * d1[3]);
        v += __shfl_xor(v, 1); v += __shfl_xor(v, 2); v += __shfl_xor(v, 4);
        const float rstd = 1.0f / sqrtf(v * (1.f / 64.f) + 64e-5f);
        float vc[8], vp[8], gg[8];
        unpack8(*(const u32x4*)(prow + (PC_V + c0) * 2), vc);
        if ((m & (SEQ - 1)) != 0) unpack8(*(const u32x4*)(prow - NPC * 2 + (PC_V + c0) * 2), vp); else {
#pragma unroll
            for (int e = 0; e < 8; ++e) vp[e] = 0.f; }
        unpack8(*(const u32x4*)(prow + (PC_G + c0) * 2), gg);
        const float bon = *(const float*)(prow + PC_PAD * 2 + h * 4);
        float o[8];
#pragma unroll
        for (int e = 0; e < 8; ++e) { const float yv = e < 4 ? d0[e] : d1[e - 4], wv = e < 4 ? w0[e] : w1[e - 4], bv = e < 4 ? b0[e] : b1[e - 4], mv = e < 4 ? m0[e] : m1[e - 4];
            const float vs = vc[e] + (vp[e] - vc[e]) * mv; const float yn = yv * rstd * wv + bv + bon * vs; o[e] = yn * (gg[e] / (1.f + __expf(-gg[e]))); }
        u32x4 w; w.x = pk2(o[0], o[1]); w.y = pk2(o[2], o[3]); w.z = pk2(o[4], o[5]); w.w = pk2(o[6], o[7]);
#ifdef DBG_ZERO_RWKV
        w = (u32x4){0u, 0u, 0u, 0u};
#endif
        *(u32x4*)(Y + (size_t)m * DM + c0) = w;
    }
}

__device__ __forceinline__ void phase_final(const Args& a, int lane, int wave, int G) {
    const int gw = blockIdx.x * 8 + wave, NGW = G * 8; const float* fg = a.in[18];
    for (int m = gw; m < MROWS; m += NGW) {
        f32x4* xr = (f32x4*)(a.out + (size_t)m * DM) + lane; f32x4 v[4]; float s = 0.f;
#pragma unroll
        for (int j = 0; j < 4; ++j) { v[j] = xr[64 * j]; s += (v[j][0] * v[j][0] + v[j][1] * v[j][1]) + (v[j][2] * v[j][2] + v[j][3] * v[j][3]); }
        const float rstd = 1.0f / sqrtf(wave_sum(s) * (1.f / DM) + 1e-6f);
#pragma unroll
        for (int j = 0; j < 4; ++j) { const f32x4 g = *(const f32x4*)(fg + 4 * lane + 256 * j); xr[64 * j] = v[j] * rstd * g; }
    }
}

#ifndef MK_PER_PHASE
#define MK_PER_PHASE 0
#endif
#ifndef PHMASK
#define PHMASK 0x1ff
#endif
#if MK_PER_PHASE
#define RUN(k) (a.ph_lo <= (k) && (k) < a.ph_hi)
#define SEAM(k) do { } while (0)
#else
#define RUN(k) true
#define SEAM(k) grid.sync()
#endif
__global__ void __launch_bounds__(512, 2) fwd_kernel(Args a) {
    extern __shared__ __attribute__((aligned(16))) unsigned char lds_raw[];
    ldsp lds = (ldsp)lds_raw;
    cg::grid_group grid = cg::this_grid();
    int tid = threadIdx.x, lane = tid & 63, wave = __builtin_amdgcn_readfirstlane(tid >> 6); const int G = gridDim.x;
#define FRESH() do { tid = threadIdx.x; asm volatile("" : "+v"(tid)); lane = tid & 63; wave = __builtin_amdgcn_readfirstlane(tid >> 6); } while (0)
    unsigned char* ws = a.ws;
    if (RUN(0)) { if (PHMASK & 1) phase_p0(a, lds, tid, lane, wave, G); }
#pragma unroll
    for (int l = 0; l < 2; ++l) {
        const int pb = 1 + 6 * l;
        const float* xin = l == 0 ? a.in[0] : a.out;
        SEAM(pb); FRESH();
        if (RUN(pb)) { if (PHMASK & 4) phase_h(a, lds, l, xin, tid, lane, wave, G); }
        SEAM(pb + 1); FRESH();
        if (RUN(pb + 1)) { if (PHMASK & 8) { pg8::Gemm g{(const bf16_t*)(ws + WS_H), (const bf16_t*)(ws + WS_WIN) + (size_t)l * NPC * DM, MROWS, NPC, DM}; pg8::StaticOrder S; S.init(MROWS, NPC, G, (int)blockIdx.x);
            pg8::EpiBf16 E{(bf16_t*)(ws + WS_P), NPC}; pg8::gemm_phase<pg8::EpiBf16, pg8::StaticOrder, true, true>(lds, g, S, E); } }
        SEAM(pb + 2); FRESH();
        if (RUN(pb + 2)) {
            if (PHMASK & 16) for (int u = blockIdx.x; u < 2048; u += G) r1_unit(a, lds, l, u, tid, lane, wave);
            const int gw = blockIdx.x * 8 + wave, NGW = G * 8;
            if (PHMASK & 32) for (int task = gw; task < 8192; task += NGW) sb_task(a, lds + wave * 4608, l, task, lane);
        }
        SEAM(pb + 3); FRESH();
        if (RUN(pb + 3)) { if (PHMASK & 64) phase_r2(a, lds, tid, lane, wave); }
        SEAM(pb + 4); FRESH();
        if (RUN(pb + 4)) { if (PHMASK & 128) phase_r3(a, l, lane, wave, G); }
        SEAM(pb + 5); FRESH();
        if (RUN(pb + 5)) { if (PHMASK & 256) { pg8::Gemm g{(const bf16_t*)(ws + WS_H), (const bf16_t*)(ws + WS_WOUT) + (size_t)l * DM * DM, MROWS, DM, DM}; pg8::StaticOrder S; S.init(MROWS, DM, G, (int)blockIdx.x);
            pg8::EpiRes E{xin, a.out, (const float*)(ws + WS_GATE) + l * 2048}; pg8::gemm_phase<pg8::EpiRes, pg8::StaticOrder, true, true>(lds, g, S, E); } }
    }
    SEAM(13); FRESH();
    if (RUN(13)) { if (PHMASK & 2) phase_final(a, lane, wave, G); }
}

#ifdef DBG_CHECK
#define ACC(k, got, want) do { const float g_ = (got), w_ = (want); const float d_ = g_ - w_; nm[k] += (d_ == d_) ? fminf(d_ * d_, 1e30f) : 1e30f; dn[k] += w_ * w_; } while (0)
__device__ __forceinline__ unsigned hsh(unsigned x) { x ^= x >> 16; x *= 0x7feb352du; x ^= x >> 15; x *= 0x846ca68bu; x ^= x >> 16; return x; }
__device__ __forceinline__ float dbg_silu(float x) { return x / (1.f + __expf(-x)); }
__device__ __forceinline__ float dbg_mod(const Args& a, int l, int b, int n) { float s = a.in[4][l * 3072 + n]; for (int k = 0; k < 1024; ++k) s += dbg_silu(a.in[1][b * 1024 + k]) * a.in[3][((size_t)l * 1024 + k) * 3072 + n]; return s; }
#define sh(col) (bf2f(pr[col]) + ((t > 0 ? bf2f(pr[(col) - NPC]) : 0.f) - bf2f(pr[col])) * mu[col])
#define DQ(Dp, mat, row, el) bf2f(*(const bf16_t*)((Dp) + (mat) * 8192 + (row) * 128 + ((((el) >> 3) ^ (((row) >> 1) & 7)) * 16) + ((el) & 7) * 2))
#define KP(jj) (32 * ((jj) >> 5) + 8 * (((jj) >> 2) & 3) + 4 * (((jj) >> 4) & 1) + ((jj) & 3))
constexpr int T0 = 7992;
__global__ void __launch_bounds__(256) dbg_check(Args a, int stage) {
    __shared__ float red[256]; __shared__ float st[64 * 65]; __shared__ float vec[8][64]; __shared__ float s64[64 * 65];
    float nm[16], dn[16];
#pragma unroll
    for (int i = 0; i < 16; ++i) { nm[i] = 0.f; dn[i] = 0.f; }
    unsigned char* ws = a.ws; float* err = (float*)(ws + WS_DBG); const int tid = threadIdx.x; float e = 0.f;
    const bf16_t* P = (const bf16_t*)(ws + WS_P); const bf16_t* Hb = (const bf16_t*)(ws + WS_H);
    if (stage == 1) {
        if (tid < 32) err[tid] = 0.f; __syncthreads();
        for (int s = tid; s < 4096; s += 256) { const unsigned r = hsh(s * 2654435761u + 17u); const int l = r & 1, n = (r >> 1) % NPC, k = (r >> 14) & 1023;
            const int sn = n < PC_PAD ? n : (n < PC_SQ ? -1 : n - 128); const float want = sn < 0 ? 0.f : bf2f(f2bf(a.in[5][((size_t)l * 1024 + k) * IN_COLS + sn]));
            ACC(1, bf2f(((const bf16_t*)(ws + WS_WIN))[((size_t)l * NPC + n) * 1024 + k]), want);
            const int n2 = n & 1023; ACC(1, bf2f(((const bf16_t*)(ws + WS_WOUT))[((size_t)l * 1024 + n2) * 1024 + k]), bf2f(f2bf(a.in[6][((size_t)l * 1024 + k) * 1024 + n2]))); }
    } else if (stage == 2) {
        for (int s = tid; s < 256; s += 256) { const unsigned r = hsh(s + 99u); const int m = r % MROWS, k = (r >> 15) & 1023, b = m >> 13;
            float ss = 0.f; for (int j = 0; j < 1024; ++j) { const float x = a.in[0][(size_t)m * 1024 + j]; ss += x * x; }
            const float rstd = 1.f / sqrtf(ss / 1024.f + 1e-6f); const float want = a.in[0][(size_t)m * 1024 + k] * rstd * a.in[2][k] * (1.f + dbg_mod(a, 0, b, 1024 + k)) + dbg_mod(a, 0, b, k);
            ACC(2, bf2f(Hb[(size_t)m * 1024 + k]), want);
            ACC(2, ((const float*)(ws + WS_GATE))[b * 1024 + k], dbg_mod(a, 0, b, 2048 + k)); }
    } else if (stage == 3) {
        for (int s = tid; s < 2048; s += 256) { const unsigned r = hsh(s + 777u); const int m = r % MROWS, n = (r >> 15) % NPC; float acc = 0.f;
            for (int k = 0; k < 1024; ++k) acc += bf2f(Hb[(size_t)m * 1024 + k]) * bf2f(((const bf16_t*)(ws + WS_WIN))[(size_t)n * 1024 + k]);
            ACC(3, bf2f(P[(size_t)m * NPC + n]), acc); }
    } else if (stage == 4) {
        const unsigned r = hsh(tid + 4242u); const int b = r & 1, h = (r >> 1) & 7; int t = (r >> 4) & 8191; if (tid < 40) t = tid;
        const bf16_t* qp = P + (size_t)(b * SEQ + t) * NPC + PC_SQ + h * 64; float* o = st + (tid & 63) * 65; for (int d = 0; d < 64; ++d) o[d] = 0.f; float after = 0.f; if (tid < 64) {
        for (int s = t - 1; s >= 0 && after > -110.f; --s) { const bf16_t* kp = P + (size_t)(b * SEQ + s) * NPC + PC_SK + h * 64; float z = 0.f; for (int d = 0; d < 64; ++d) z += bf2f(qp[d]) * bf2f(kp[d]); z *= 0.125f;
            const float sp = fmaxf(z, 0.f) + __logf(1.f + __expf(-fabsf(z))); const float w = __expf(z - sp + after); const bf16_t* vp = P + (size_t)(b * SEQ + s) * NPC + PC_SV + h * 64;
            for (int d = 0; d < 64; ++d) o[d] += w * bf2f(vp[d]); after -= sp; }
        float ss = 0.f; for (int d = 0; d < 64; ++d) ss += o[d] * o[d]; const float rms = 1.f / sqrtf(ss / 64.f + 1e-6f);
        for (int d = 0; d < 64; ++d) { const float g = bf2f(P[(size_t)(b * SEQ + t) * NPC + PC_SG + h * 64 + d]); const float want = o[d] * rms * a.in[17][h * 64 + d] * dbg_silu(g);
            ACC(4, bf2f(Hb[(size_t)(b * SEQ + t) * 1024 + 512 + h * 64 + d]), want); } }
    } else if (stage == 5 || stage == 6) {
        if (tid < 64) { const int b = stage == 5 ? 0 : 1, h = stage == 5 ? 0 : 5, j = tid, jg = h * 64 + j; const float* mu = a.in[7];
            for (int x = 0; x < 64; ++x) st[tid * 65 + x] = 0.f;
            float pd = 1.f;
            float* expy = (float*)(ws + WS_DBG + 4096) + (stage - 5) * 200 * 64;
            for (int t = 0; t < T0 + 200; ++t) { const bf16_t* pr = P + (size_t)(b * SEQ + t) * NPC;
                const float rr = sh(PC_R + jg), kr = sh(PC_K + jg), vv = sh(PC_V + jg); float wa = a.in[8][jg], aa = a.in[10][jg];
                for (int m = 0; m < 64; ++m) { wa += tanh_f(sh(PC_ZW + m)) * a.in[9][(size_t)m * 512 + jg]; aa += sh(PC_ZA + m) * a.in[11][(size_t)m * 512 + jg]; }
                const float sp = fmaxf(-wa, 0.f) + __logf(1.f + __expf(-fabsf(wa))); const float dec = __expf(-__expf(-sp - 0.5f)); const float av = 1.f / (1.f + __expf(-aa));
                float kk = kr * a.in[12][jg]; vec[6][j] = kk * kk; __syncthreads(); float n2 = 0.f; for (int x = 0; x < 64; ++x) n2 += vec[6][x]; kk *= 1.f / sqrtf(fmaxf(n2, 1e-24f));
                const float kp = kr * (1.f + (av - 1.f) * a.in[13][jg]);
                vec[0][j] = rr; vec[1][j] = dec; vec[2][j] = kp; vec[3][j] = vv; vec[4][j] = kk; vec[5][j] = kk * av; vec[7][j] = rr * kp * a.in[14][jg]; __syncthreads();
                float sa = 0.f; for (int x = 0; x < 64; ++x) sa += st[tid * 65 + x] * -vec[4][x];
                float y = 0.f; for (int x = 0; x < 64; ++x) { float s2 = st[tid * 65 + x] * vec[1][x] + sa * vec[5][x] + vec[3][tid] * vec[2][x]; st[tid * 65 + x] = s2; y += s2 * vec[0][x]; }
                float bon = 0.f; for (int x = 0; x < 64; ++x) bon += vec[7][x];
                __syncthreads(); vec[6][j] = y; __syncthreads(); float mean = 0.f; for (int x = 0; x < 64; ++x) mean += vec[6][x]; mean /= 64.f; float var = 0.f; for (int x = 0; x < 64; ++x) var += (vec[6][x] - mean) * (vec[6][x] - mean); var /= 64.f;
                const float yn = (y - mean) / sqrtf(var + 64e-5f) * a.in[15][jg] + a.in[16][jg] + bon * vv; const float g = bf2f(pr[PC_G + jg]);
                if (t >= T0) expy[(t - T0) * 64 + j] = y; if (t >= T0) expy[2 * 200 * 64 + (t - T0) * 64 + j] = yn * dbg_silu(g);
                { const int u0 = (b * 8 + h) * 128; const unsigned char* D0 = ws + WS_D + (size_t)u0 * 32768; const unsigned char* D1 = D0 + 32768; const int i = tid;
                  pd *= dec;
                  if (t < 64) ACC(11, DQ(D0, 3, i, t), y);
                  if (t == 63) { for (int x = 0; x < 64; ++x) { ACC(10, DQ(D0, 2, i, x), st[i * 65 + x]); s64[i * 65 + x] = st[i * 65 + x]; }
                      ACC(12, ((const float*)(ws + WS_GAM))[(size_t)u0 * 64 + j], pd); }
                  if (t >= 64 && t < 128) { float yp = DQ(D1, 3, i, t - 64); for (int x = 0; x < 64; ++x) yp += DQ(D1, 1, t - 64, KP(x)) * s64[i * 65 + x]; ACC(15, yp, y); }
                  if (t == 127) { for (int jp = 0; jp < 64; ++jp) { float sp2 = ((const float*)(ws + WS_GAM))[(size_t)(u0 + 1) * 64 + jp] * s64[i * 65 + jp] + DQ(D1, 2, i, jp);
                          for (int x = 0; x < 64; ++x) sp2 += DQ(D1, 0, jp, KP(x)) * s64[i * 65 + x]; ACC(14, sp2, st[i * 65 + jp]); } }
                }
                __syncthreads(); }
            }
    } else if (stage == 7 || stage == 8) {
        const float* expy = (const float*)(ws + WS_DBG + 4096);
        for (int which = 0; which < 2; ++which) { const int b = which ? 1 : 0, h = which ? 5 : 0;
            for (int s = tid; s < 200 * 64; s += 256) { const int t = s >> 6, j = s & 63;
                if (stage == 7) { const float gv = *(const float*)((const unsigned char*)P + (size_t)(b * SEQ + T0 + t) * NPC * 2 + (h * 64 + j) * 4); if (t < 64) ACC(7, gv, expy[which * 200 * 64 + s]); else ACC(13, gv, expy[which * 200 * 64 + s]); }
                else ACC(8, bf2f(Hb[(size_t)(b * SEQ + T0 + t) * 1024 + h * 64 + j]), expy[2 * 200 * 64 + which * 200 * 64 + s]); } }
    } else if (stage == 9) {
        for (int s = tid; s < 1024; s += 256) { const unsigned r = hsh(s + 31337u); const int m = r % MROWS, n = (r >> 15) & 1023, b = m >> 13; float acc = 0.f;
            for (int k = 0; k < 1024; ++k) acc += bf2f(Hb[(size_t)m * 1024 + k]) * bf2f(((const bf16_t*)(ws + WS_WOUT))[(size_t)n * 1024 + k]);
            ACC(9, a.out[(size_t)m * 1024 + n], a.in[0][(size_t)m * 1024 + n] + ((const float*)(ws + WS_GATE))[b * 1024 + n] * acc); }
    } else if (stage == 20) {
        const unsigned char* dump = ws + WS_DUMP; float* REF = (float*)(ws + WS_DUMP + 156672);
        float* Rr = REF, *Rc = REF + 4096, *Rkp = REF + 8192, *Rv = REF + 12288, *Rkk = REF + 16384, *Ra = REF + 20480;
        { const int t = tid >> 2, jq = tid & 3; const bf16_t* pr = P + (size_t)t * NPC; const float* mu = a.in[7]; float n2 = 0.f;
          for (int jj = 0; jj < 16; ++jj) { const int j = jq * 16 + jj; const float kr = sh(PC_K + j); const float kk = kr * a.in[12][j]; n2 += kk * kk; }
          n2 += __shfl_xor(n2, 1); n2 += __shfl_xor(n2, 2); const float rn = 1.f / sqrtf(fmaxf(n2, 1e-24f));
          for (int jj = 0; jj < 16; ++jj) { const int j = jq * 16 + jj; const float rr = sh(PC_R + j), kr = sh(PC_K + j), vv = sh(PC_V + j); float wa = a.in[8][j], aa = a.in[10][j];
              for (int m = 0; m < 64; ++m) { wa += tanh_f(sh(PC_ZW + m)) * a.in[9][(size_t)m * 512 + j]; aa += sh(PC_ZA + m) * a.in[11][(size_t)m * 512 + j]; }
              const float sp = fmaxf(-wa, 0.f) + __logf(1.f + __expf(-fabsf(wa))); const float av = 1.f / (1.f + __expf(-aa));
              Rr[t * 64 + j] = rr; Rc[t * 64 + j] = -__expf(-sp - 0.5f); Rkp[t * 64 + j] = kr * (1.f + (av - 1.f) * a.in[13][j]); Rv[t * 64 + j] = vv; Rkk[t * 64 + j] = kr * a.in[12][j] * rn; Ra[t * 64 + j] = av; } }
        __threadfence(); __syncthreads();
        if (tid < 64) { float c = 0.f; for (int t = 0; t < 64; ++t) { c += Rc[t * 64 + tid]; Rc[t * 64 + tid] = c; } }
        __threadfence(); __syncthreads();
#define DM_(off, row, col) bf2f(*(const bf16_t*)(dump + (off) + (row) * 144 + (col) * 2))
        for (int s = tid; s < 4096; s += 256) { const int t = s >> 6, j = s & 63; const float ci = Rc[s], ce = t ? Rc[s - 64] : 0.f, ct = Rc[63 * 64 + j], kk = Rkk[s], av = Ra[s], kp = Rkp[s];
            const float Ag = -kk * __expf(ce), Rg = Rr[s] * __expf(ci), Bg = kk * av * __expf(-ci), Kg = kp * __expf(-ci);
            ACC(1, DM_(0, t, j), Ag); ACC(2, DM_(9216, t, j), Rg); ACC(3, DM_(18432, t, j), Bg); ACC(4, DM_(27648, t, j), Kg);
            ACC(5, DM_(36864, j, t), Ag); ACC(6, DM_(46080, j, t), kk * av * __expf(ct - ci)); ACC(6, DM_(55296, j, t), kp * __expf(ct - ci)); ACC(7, DM_(64512, j, t), Rv[s]); }
        for (int s = tid; s < 4096; s += 256) { const int t = s >> 6, u_ = s & 63; float ab = 0.f, ak = 0.f, rb = 0.f, rk = 0.f;
            for (int j = 0; j < 64; ++j) { const float ag = DM_(0, t, j), rg = DM_(9216, t, j), bg = DM_(18432, u_, j), kg = DM_(27648, u_, j); ab += ag * bg; ak += ag * kg; rb += rg * bg; rk += rg * kg; }
            if (!(u_ < t)) { ab = 0.f; ak = 0.f; } if (!(u_ <= t)) { rb = 0.f; rk = 0.f; }
            ACC(8, DM_(73728, t, u_), ab); ACC(8, DM_(73728 + 9216, u_, t), ab); ACC(9, DM_(92160, t, u_), ak); ACC(9, DM_(92160 + 9216, t, u_), rb); ACC(9, DM_(92160 + 18432, t, u_), rk); }
        if (tid < 64) { for (int t = 0; t < 64; ++t) { float v = (t == tid) ? 1.f : 0.f; for (int k = 0; k < t; ++k) v += DM_(73728, t, k) * st[k * 65 + tid]; st[t * 65 + tid] = v; } }
        __syncthreads();
        for (int s = tid; s < 4096; s += 256) { const int t = s >> 6, u_ = s & 63; ACC(10, DM_(119808, t, u_), st[t * 65 + u_]);
            float akv = 0.f; for (int k = 0; k < 64; ++k) akv += DM_(92160, u_, k) * DM_(64512, t, k);
            ACC(11, DM_(129024, t, u_), akv); ACC(14, DM_(-49152, t, u_), akv); }
        for (int s = tid; s < 8192; s += 256) { const int n = s >> 6, t = s & 63; float x = 0.f; for (int k = 0; k < 64; ++k) x += DM_(119808, t, k) * (n < 64 ? DM_(36864, n, k) : DM_(129024, n - 64, k));
            ACC(12, DM_(138240, n, t), x); }
        { const unsigned char* D0 = ws + WS_D;
          for (int s = tid; s < 4096; s += 256) { const int r_ = s >> 6, c_ = s & 63; float pp = 0.f, y0 = 0.f;
              for (int k = 0; k < 64; ++k) { pp += DM_(46080, r_, k) * DM_(138240, c_, k); y0 += DM_(92160 + 9216, c_, k) * DM_(138240, 64 + r_, k) + DM_(92160 + 18432, c_, k) * DM_(64512, r_, k); }
              ACC(13, DQ(D0, 0, r_, KP(c_)), pp); ACC(13, DQ(D0, 3, r_, c_), y0); } }
    } else if (stage == 30) {
        for (int s = tid; s < 256; s += 256) { const unsigned r = hsh(s + 555u); const int m = r % MROWS, k = (r >> 15) & 1023, b = m >> 13;
            float ss = 0.f; for (int j = 0; j < 1024; ++j) { const float x = a.out[(size_t)m * 1024 + j]; ss += x * x; }
            const float rstd = 1.f / sqrtf(ss / 1024.f + 1e-6f); const float want = a.out[(size_t)m * 1024 + k] * rstd * a.in[2][1024 + k] * (1.f + dbg_mod(a, 1, b, 1024 + k)) + dbg_mod(a, 1, b, k);
            ACC(5, bf2f(Hb[(size_t)m * 1024 + k]), want);
            ACC(5, ((const float*)(ws + WS_GATE))[2048 + b * 1024 + k], dbg_mod(a, 1, b, 2048 + k)); }
    } else if (stage == 31) {
        for (int s = tid; s < 256; s += 256) { const unsigned r = hsh(s + 888u); const int m = r % MROWS; float ss = 0.f;
            for (int j = 0; j < 1024; ++j) { const float x = a.out[(size_t)m * 1024 + j] / a.in[18][j]; ss += x * x; } ACC(6, ss / 1024.f, 1.f); }
    } else if (stage == 99) {
        for (int i = tid; i < MROWS * DM; i += 256) a.out[i] = 0.f;
        __syncthreads();
        if (tid == 0) { for (int k = 1; k <= 14; ++k) if (!(err[16 + k] < 0.03f)) { a.out[0] = (float)(10 + k) * 1e6f; return; } }
        if (tid == 0) { const float th[9] = {0.003f, 0.005f, 0.01f, 0.02f, 0.03f, 0.05f, 0.1f, 0.3f, 1.0f}; int c8 = 9, c13 = 9, c5 = 9, c6 = 9;
            for (int i = 8; i >= 0; --i) { if (err[8] < th[i]) c8 = i; if (err[13] < th[i]) c13 = i; if (err[5] < th[i]) c5 = i; if (err[6] < th[i]) c6 = i; }
            float pw = 1e6f; for (int z = 0; z < c5 + (c6 > 4 ? 10 : 0); ++z) pw *= 10.f; a.out[0] = (float)(10 * (1 + (c8 > 8 ? 8 : c8)) + c13) * pw; return; }
        if (tid == 0) { const int lo[6] = {7, 13, 10, 11, 12, 14}; const int hi[4] = {15, 8, 9, 0}; int lb = 0, hb = 0;
            for (int i = 0; i < 6; ++i) if (!(err[lo[i]] < 0.03f)) lb |= 1 << i;
            for (int i = 0; i < 3; ++i) if (!(err[hi[i]] < 0.03f)) hb |= 1 << i;
            if (!(err[1] < 0.03f) || !(err[2] < 0.03f) || !(err[3] < 0.03f) || !(err[4] < 0.03f)) hb |= 8;
            if (lb | hb) { float pw = 1e4f; for (int z = 0; z < hb; ++z) pw *= 10.f; a.out[0] = (float)(10 + lb) * pw; } }
        return;
    }
    __syncthreads();
#pragma unroll
    for (int k = 1; k < 16; ++k) { if (stage == 6 && k >= 10) continue; if ((stage == 5 || stage == 6) && k < 10) continue; red[tid] = nm[k]; __syncthreads(); float n_ = 0.f; if (tid == 0) for (int i = 0; i < 256; ++i) n_ += red[i]; __syncthreads(); red[tid] = dn[k]; __syncthreads();
        if (tid == 0) { float d_ = 0.f; for (int i = 0; i < 256; ++i) d_ += red[i]; if (n_ > 0.f || d_ > 0.f) err[(stage == 20 ? 16 : 0) + k] = sqrtf(n_ / (d_ + 1e-30f)); } __syncthreads(); }
}
#endif
extern "C" void kernel_launch(void* const* d_in, const int* in_sizes, int n_in, void* d_out, int out_size, void* d_ws, size_t ws_size, hipStream_t stream) {
    static int grid = 0;
    if (grid == 0) {
        if (n_in != 19 || out_size != MROWS * DM || ws_size < WS_END) { fprintf(stderr, "kernel_launch: unexpected shapes (n_in %d, out %d, ws %zu)\n", n_in, out_size, ws_size); grid = -1; return; }
        int dev = 0, cus = 0, per_cu = 0;
        (void)hipGetDevice(&dev); (void)hipDeviceGetAttribute(&cus, hipDeviceAttributeMultiprocessorCount, dev);
        if (hipFuncSetAttribute((const void*)fwd_kernel, hipFuncAttributeMaxDynamicSharedMemorySize, LDS_BYTES) != hipSuccess) { fprintf(stderr, "kernel_launch: hipFuncSetAttribute failed\n"); grid = -1; return; }
        if (hipOccupancyMaxActiveBlocksPerMultiprocessor(&per_cu, (const void*)fwd_kernel, 512, LDS_BYTES) != hipSuccess || per_cu < 1) { fprintf(stderr, "kernel_launch: occupancy query says %d\n", per_cu); per_cu = 1; }
        (void)hipGetLastError();
        grid = cus * 1;
        if (grid < 16) { grid = -1; return; }
    }
    if (grid < 0) return;
    Args a{};
    for (int i = 0; i < 19; ++i) a.in[i] = (const float*)d_in[i];
    a.out = (float*)d_out; a.ws = (unsigned char*)d_ws;
#if MK_PER_PHASE
    for (int ph = 0; ph < NPHASE; ++ph) { a.ph_lo = ph; a.ph_hi = ph + 1; hipLaunchKernelGGL(fwd_kernel, dim3(grid), dim3(512), LDS_BYTES, stream, a);
#ifdef DBG_CHECK
        if (ph == 0) hipLaunchKernelGGL(dbg_check, dim3(1), dim3(256), 0, stream, a, 1);
        if (ph == 1) hipLaunchKernelGGL(dbg_check, dim3(1), dim3(256), 0, stream, a, 2);
        if (ph == 2) hipLaunchKernelGGL(dbg_check, dim3(1), dim3(256), 0, stream, a, 3);
        if (ph == 3) { hipLaunchKernelGGL(dbg_check, dim3(1), dim3(256), 0, stream, a, 20); hipLaunchKernelGGL(dbg_check, dim3(1), dim3(256), 0, stream, a, 4); hipLaunchKernelGGL(dbg_check, dim3(1), dim3(256), 0, stream, a, 5); hipLaunchKernelGGL(dbg_check, dim3(1), dim3(256), 0, stream, a, 6); }
        if (ph == 4) hipLaunchKernelGGL(dbg_check, dim3(1), dim3(256), 0, stream, a, 7);
        if (ph == 5) hipLaunchKernelGGL(dbg_check, dim3(1), dim3(256), 0, stream, a, 8);
        if (ph == 6) hipLaunchKernelGGL(dbg_check, dim3(1), dim3(256), 0, stream, a, 9);
        if (ph == 7) hipLaunchKernelGGL(dbg_check, dim3(1), dim3(256), 0, stream, a, 30);
        if (ph == NPHASE - 1) { hipLaunchKernelGGL(dbg_check, dim3(1), dim3(256), 0, stream, a, 31); hipLaunchKernelGGL(dbg_check, dim3(1), dim3(256), 0, stream, a, 99); }
#endif
    }
#else
    a.ph_lo = 0; a.ph_hi = NPHASE;
    void* args[] = {&a};
    hipError_t e = hipLaunchCooperativeKernel((const void*)fwd_kernel, dim3(grid), dim3(512), args, LDS_BYTES, stream);
    if (e != hipSuccess) fprintf(stderr, "cooperative launch failed: %s (grid %d)\n", hipGetErrorString(e), grid);
#endif
}
```

```cpp
#include <hip/hip_runtime.h>
#include <hip/hip_cooperative_groups.h>
#include <cstdio>
#include <cstdint>
namespace cg = cooperative_groups;
namespace pg8 {
#define PG8_LAS __attribute__((address_space(3)))
typedef unsigned short bf16_t;
typedef short bf16x8 __attribute__((ext_vector_type(8)));
typedef float f32x4 __attribute__((ext_vector_type(4)));
typedef unsigned u32x4 __attribute__((ext_vector_type(4)));
constexpr int BM = 256, BK = 64, HALF = 128, HTB = HALF * BK * 2  , STAGE_BYTES = 8 * HTB, NXCD = 8, WGM = 8;

__host__ __device__ __forceinline__ int lds_byte(int r, int c) { const int st = (r >> 4) * 2 + (c >> 5), rr = r & 15, cc = c & 31, ob = rr * 64 + cc * 2; return st * 1024 + (ob ^ (((ob >> 9) & 1) << 5)); }
__host__ __device__ __forceinline__ void stage_rc(int b, int& R, int& C) { const int st = b / 1024, sb = b % 1024, swz = sb ^ (((sb >> 9) & 1) << 5); R = (st >> 1) * 16 + swz / 64; C = (st & 1) * 32 + (swz % 64) / 2; }
__host__ __device__ __forceinline__ int perm32(int rho) { const int n = rho >> 4, i = rho & 15; return 8 * (i >> 2) + 4 * n + (i & 3); }

struct Unit { int pm, pn; };
struct Gemm { const bf16_t* A; const bf16_t* Bt; int M, N, K; };

struct StaticOrder {
    int nM, nN, nwg, G, c;
    __host__ __device__ void init(int M, int N, int G_, int c_) { nM = M / BM; nN = N / BM; nwg = nM * nN; G = G_; c = c_; }
    __host__ __device__ bool next(int i, Unit& u) const {
        const long L = (long)i * G + c; if (L >= nwg) return false;
        int wgid = (int)L; { const int q = nwg / NXCD, r = nwg % NXCD, xcd = wgid % NXCD, off = wgid / NXCD; wgid = (xcd < r ? xcd * (q + 1) : r * (q + 1) + (xcd - r) * q) + off; }
        const int nig = WGM * nN, gid = wgid / nig, fm = gid * WGM, gsz = (nM - fm) < WGM ? (nM - fm) : WGM;
        u.pm = fm + ((wgid % nig) % gsz); u.pn = (wgid % nig) / gsz; return true;
    }
    __device__ __forceinline__ void a_ready(const Unit&) const {}
    __device__ __forceinline__ void done(const Unit&) const {}
};

typedef __bf16 bf16v2_t __attribute__((ext_vector_type(2)));
typedef float f32v2_t __attribute__((ext_vector_type(2)));
__device__ __forceinline__ unsigned cvt_pk_bf16(float lo, float hi) { f32v2_t v = {lo, hi}; bf16v2_t b = __builtin_convertvector(v, bf16v2_t); return __builtin_bit_cast(unsigned, b); }
struct EpiBf16 {
    static constexpr bool PERM = true, AFTER_DRAIN = false;
    bf16_t* O; int ldc;
    __device__ __forceinline__ void operator()(const f32x4 (&acc)[2][2][4][2], const Unit& u, int wr, int wc, int fr, int fq) const {
        const int row0 = u.pm * BM + wr * 64 + fr; const int col0 = u.pn * BM + wc * 32 + 8 * fq;
#pragma unroll
        for (int ai = 0; ai < 2; ++ai)
#pragma unroll
            for (int m = 0; m < 4; ++m) { bf16_t* rowp = O + (size_t)(row0 + ai * HALF + m * 16) * ldc + col0;
#pragma unroll
                for (int bj = 0; bj < 2; ++bj) { const f32x4 v0 = acc[ai][bj][m][0], v1 = acc[ai][bj][m][1];
                    u32x4 w; w.x = cvt_pk_bf16(v0[0], v0[1]); w.y = cvt_pk_bf16(v0[2], v0[3]); w.z = cvt_pk_bf16(v1[0], v1[1]); w.w = cvt_pk_bf16(v1[2], v1[3]);
                    *(u32x4*)(rowp + bj * HALF) = w; } }
    }
    __device__ __forceinline__ void fused(f32x4 (&)[2][2][4][2], const Unit&, int, int, int, int, PG8_LAS unsigned char*, int, int) const {}
};
struct EpiRes {
    static constexpr bool PERM = false, AFTER_DRAIN = false;
    const float* xin; float* out; const float* gate;
    __device__ __forceinline__ void operator()(const f32x4 (&acc)[2][2][4][2], const Unit& u, int wr, int wc, int fr, int fq) const {
        const int row0 = u.pm * BM + wr * 64 + fr; const int col0 = u.pn * BM + wc * 32 + 4 * fq; const float* gp = gate + ((u.pm * BM) >> 13) * 1024;
        f32x4 gv[2][2];
#pragma unroll
        for (int bj = 0; bj < 2; ++bj)
#pragma unroll
            for (int n = 0; n < 2; ++n) gv[bj][n] = *(const f32x4*)(gp + col0 + bj * HALF + n * 16);
#pragma unroll
        for (int ai = 0; ai < 2; ++ai)
#pragma unroll
            for (int m = 0; m < 4; ++m) { const size_t off = (size_t)(row0 + ai * HALF + m * 16) * 1024 + col0;
#pragma unroll
                for (int bj = 0; bj < 2; ++bj)
#pragma unroll
                    for (int n = 0; n < 2; ++n) { const f32x4 xv = *(const f32x4*)(xin + off + bj * HALF + n * 16);
                        *(f32x4*)(out + off + bj * HALF + n * 16) = xv + gv[bj][n] * acc[ai][bj][m][n]; } }
    }
    __device__ __forceinline__ void fused(f32x4 (&)[2][2][4][2], const Unit&, int, int, int, int, PG8_LAS unsigned char*, int, int) const {}
};
template <class Epi, class Sched, bool ALIGN_EPI = false, bool SP2 = false>
__device__ __forceinline__ void gemm_phase(PG8_LAS unsigned char* lds, const Gemm g, const Sched& S, const Epi& E) {
    const int tid = threadIdx.x, wid = __builtin_amdgcn_readfirstlane(tid >> 6), lane = tid & 63, wr = wid >> 2, wc = wid & 3, fr = lane & 15, fq = lane >> 4;
    const int K = g.K, nt = K / BK;
    unsigned voffA[2], voffB[2];
#pragma unroll
    for (int i = 0; i < 2; ++i) { int R, C; stage_rc(tid * 16 + i * 8192, R, C); const int Rb = Epi::PERM ? ((R & ~31) + perm32(R & 31)) : R;
        voffA[i] = (unsigned)(R * K + C) * 2u; voffB[i] = (unsigned)(Rb * K + C) * 2u; }
    const size_t kstep = (size_t)(BK * 2);
    const size_t hstep = (size_t)HALF * K * 2;
    const size_t tstep = 2 * hstep;
    const unsigned ldsw = (unsigned)wid * 1024u;
    const int aoff = lds_byte(wr * 64 + fr, fq * 8), boff = lds_byte(wc * 32 + fr, fq * 8);
#define PG8_SA(b, h) (((b) * 2 + (h)) * HTB)
#define PG8_SB(b, h) ((4 + (b) * 2 + (h)) * HTB)
#define PG8_STAGE(bufoff, gbase, voff) do { _Pragma("unroll") for (int _i = 0; _i < 2; ++_i) \
        __builtin_amdgcn_global_load_lds((const unsigned*)((const char*)(gbase) + (voff)[_i]), (PG8_LAS unsigned*)(lds + (bufoff) + ldsw + _i * 8192), 16, 0, 0); } while (0)
#define PG8_LDA(dst, b, h) do { _Pragma("unroll") for (int m = 0; m < 4; ++m) _Pragma("unroll") for (int k = 0; k < 2; ++k) dst[m][k] = *(const PG8_LAS bf16x8*)(lds + PG8_SA(b, h) + aoff + m * 2048 + k * 1024); } while (0)
#define PG8_LDB(dst, b, h) do { _Pragma("unroll") for (int n = 0; n < 2; ++n) _Pragma("unroll") for (int k = 0; k < 2; ++k) dst[n][k] = *(const PG8_LAS bf16x8*)(lds + PG8_SB(b, h) + boff + n * 2048 + k * 1024); } while (0)
#define PG8_MMA(ai, bj, At, Bt) do { __builtin_amdgcn_s_setprio(1); _Pragma("unroll") for (int m = 0; m < 4; ++m) _Pragma("unroll") for (int n = 0; n < 2; ++n) _Pragma("unroll") for (int k = 0; k < 2; ++k) \
        acc[ai][bj][m][n] = __builtin_amdgcn_mfma_f32_16x16x32_bf16(Bt[n][k], At[m][k], acc[ai][bj][m][n], 0, 0, 0); __builtin_amdgcn_s_setprio(0); } while (0)
#define PG8_WAIT_V(n) asm volatile("s_waitcnt vmcnt(" #n ")" ::: "memory")
#define PG8_WAIT_L(n) asm volatile("s_waitcnt lgkmcnt(" #n ")" ::: "memory")
#define PG8_BAR __builtin_amdgcn_s_barrier()
#define PG8_SCHED __builtin_amdgcn_sched_barrier(0)
    Unit cur, nxt; int ui = 0;
    if (!S.next(0, cur)) return;
    f32x4 acc[2][2][4][2];
#pragma unroll
    for (int a = 0; a < 2; ++a)
#pragma unroll
        for (int b = 0; b < 2; ++b)
#pragma unroll
            for (int m = 0; m < 4; ++m)
#pragma unroll
                for (int n = 0; n < 2; ++n) acc[a][b][m][n] = (f32x4){0.f, 0.f, 0.f, 0.f};
    bf16x8 At[4][2], B0[2][2], B1[2][2];
    const char* cA = (const char*)g.A + (size_t)cur.pm * tstep; const char* cB = (const char*)g.Bt + (size_t)cur.pn * tstep;
    S.a_ready(cur);
    if constexpr (SP2) {
        PG8_STAGE(PG8_SB(0, 0), cB, voffB); PG8_STAGE(PG8_SB(0, 1), cB + hstep, voffB); PG8_STAGE(PG8_SA(0, 0), cA, voffA); PG8_STAGE(PG8_SA(0, 1), cA + hstep, voffA);
        if (wr == 1) PG8_BAR;
        PG8_WAIT_V(2); PG8_BAR;
        PG8_STAGE(PG8_SB(1, 0), cB + kstep, voffB); PG8_STAGE(PG8_SA(1, 0), cA + kstep, voffA); PG8_STAGE(PG8_SB(1, 1), cB + hstep + kstep, voffB);
        PG8_WAIT_V(6); PG8_BAR;
    } else {
        PG8_STAGE(PG8_SB(0, 0), cB, voffB); PG8_STAGE(PG8_SA(0, 0), cA, voffA); PG8_STAGE(PG8_SB(0, 1), cB + hstep, voffB); PG8_STAGE(PG8_SA(0, 1), cA + hstep, voffA);
        if (wr == 1) PG8_BAR;
        PG8_WAIT_V(4); PG8_BAR;
        PG8_STAGE(PG8_SB(1, 0), cB + kstep, voffB); PG8_STAGE(PG8_SA(1, 0), cA + kstep, voffA); PG8_STAGE(PG8_SB(1, 1), cB + hstep + kstep, voffB);
        PG8_WAIT_V(6); PG8_BAR;
    }
    for (;;) {
        const bool has_next = S.next(ui + 1, nxt);
        const char* nA = has_next ? (const char*)g.A + (size_t)nxt.pm * tstep : cA; const char* nB = has_next ? (const char*)g.Bt + (size_t)nxt.pn * tstep : cB;
        for (int t = 0; t < nt; t += 2) {
            const bool last = (t == nt - 2);
            const char* a1 = cA + (size_t)(t + 1) * kstep;
            const char* a2 = last ? nA : cA + (size_t)(t + 2) * kstep; const char* b2 = last ? nB : cB + (size_t)(t + 2) * kstep;
            const char* a3 = a2 + kstep; const char* b3 = b2 + kstep;
            if (last && has_next) S.a_ready(nxt);
            if constexpr (SP2) {
            PG8_LDB(B0, 0, 0); PG8_LDB(B1, 0, 1); PG8_SCHED; PG8_LDA(At, 0, 0); PG8_STAGE(PG8_SA(1, 1), a1 + hstep, voffA);
            PG8_WAIT_V(8); PG8_WAIT_L(0); PG8_BAR; PG8_MMA(0, 0, At, B0); PG8_MMA(0, 1, At, B1); PG8_BAR; PG8_SCHED;
            PG8_LDA(At, 0, 1); PG8_STAGE(PG8_SB(0, 0), b2, voffB); PG8_STAGE(PG8_SB(0, 1), b2 + hstep, voffB); PG8_STAGE(PG8_SA(0, 0), a2, voffA);
            PG8_WAIT_V(8); PG8_WAIT_L(0); PG8_BAR; PG8_MMA(1, 0, At, B0); PG8_MMA(1, 1, At, B1); PG8_BAR; PG8_SCHED;
            PG8_LDB(B0, 1, 0); PG8_LDB(B1, 1, 1); PG8_SCHED; PG8_LDA(At, 1, 0); PG8_STAGE(PG8_SA(0, 1), a2 + hstep, voffA);
            PG8_WAIT_V(8); PG8_WAIT_L(0); PG8_BAR; PG8_MMA(0, 0, At, B0); PG8_MMA(0, 1, At, B1); PG8_BAR; PG8_SCHED;
            PG8_LDA(At, 1, 1); PG8_STAGE(PG8_SB(1, 0), b3, voffB); PG8_STAGE(PG8_SB(1, 1), b3 + hstep, voffB); PG8_STAGE(PG8_SA(1, 0), a3, voffA);
            PG8_WAIT_V(8); PG8_WAIT_L(0); PG8_BAR; PG8_MMA(1, 0, At, B0); PG8_MMA(1, 1, At, B1); PG8_BAR; PG8_SCHED;
            } else {
            PG8_LDB(B0, 0, 0); PG8_SCHED; PG8_LDA(At, 0, 0); PG8_STAGE(PG8_SA(1, 1), a1 + hstep, voffA);
            PG8_WAIT_L(8); PG8_BAR; PG8_WAIT_L(0); PG8_MMA(0, 0, At, B0); PG8_BAR; PG8_SCHED;
            PG8_LDB(B1, 0, 1); PG8_STAGE(PG8_SB(0, 0), b2, voffB);
            PG8_BAR; PG8_WAIT_L(0); PG8_MMA(0, 1, At, B1); PG8_BAR;
            PG8_LDA(At, 0, 1); PG8_STAGE(PG8_SA(0, 0), a2, voffA);
            PG8_BAR; PG8_WAIT_L(0); PG8_MMA(1, 0, At, B0); PG8_BAR; PG8_SCHED;
            PG8_STAGE(PG8_SB(0, 1), b2 + hstep, voffB);
            PG8_WAIT_V(6); PG8_BAR; PG8_MMA(1, 1, At, B1); PG8_BAR;
            PG8_LDB(B0, 1, 0); PG8_SCHED; PG8_LDA(At, 1, 0); PG8_STAGE(PG8_SA(0, 1), a2 + hstep, voffA);
            PG8_WAIT_L(8); PG8_BAR; PG8_WAIT_L(0); PG8_MMA(0, 0, At, B0); PG8_BAR; PG8_SCHED;
            PG8_LDB(B1, 1, 1); PG8_STAGE(PG8_SB(1, 0), b3, voffB);
            PG8_BAR; PG8_WAIT_L(0); PG8_MMA(0, 1, At, B1); PG8_BAR;
            PG8_LDA(At, 1, 1); PG8_STAGE(PG8_SA(1, 0), a3, voffA);
            PG8_BAR; PG8_WAIT_L(0); PG8_MMA(1, 0, At, B0); PG8_BAR; PG8_SCHED;
            PG8_STAGE(PG8_SB(1, 1), b3 + hstep, voffB);
            PG8_WAIT_V(6); PG8_BAR; PG8_MMA(1, 1, At, B1); PG8_BAR;
            }
        }
        if constexpr (ALIGN_EPI) { if (wr == 0) PG8_BAR; }
        if constexpr (!Epi::AFTER_DRAIN) { E(acc, cur, wr, wc, fr, fq); S.done(cur); }
        if (!has_next) break;
#pragma unroll
        for (int a = 0; a < 2; ++a)
#pragma unroll
            for (int b = 0; b < 2; ++b)
#pragma unroll
                for (int m = 0; m < 4; ++m)
#pragma unroll
                    for (int n = 0; n < 2; ++n) acc[a][b][m][n] = (f32x4){0.f, 0.f, 0.f, 0.f};
        cur = nxt; cA = nA; cB = nB; ++ui;
        if constexpr (ALIGN_EPI) { if (wr == 1) PG8_BAR; }
    }
    PG8_WAIT_V(0);
    if constexpr (!ALIGN_EPI) { if (wr == 0) PG8_BAR; }
    PG8_BAR;
    if constexpr (Epi::AFTER_DRAIN) { E.fused(acc, cur, wr, wc, fr, fq, lds, wid, lane); S.done(cur); }
#undef PG8_SA
#undef PG8_SB
#undef PG8_STAGE
#undef PG8_LDA
#undef PG8_LDB
#undef PG8_MMA
#undef PG8_WAIT_V
#undef PG8_WAIT_L
#undef PG8_BAR
#undef PG8_SCHED
}
}
#define LAS __attribute__((address_space(3)))
typedef unsigned short bf16_t;
typedef short bf16x8 __attribute__((ext_vector_type(8)));
typedef float f32x4 __attribute__((ext_vector_type(4)));
typedef unsigned u32x4 __attribute__((ext_vector_type(4)));
typedef unsigned u32x2 __attribute__((ext_vector_type(2)));
typedef LAS unsigned char* ldsp;

constexpr int BATCH = 2, SEQ = 8192, DM = 1024, MROWS = BATCH * SEQ, NH = 8, HD = 64, RWW = 512;
constexpr int NPC = 4352;
constexpr int PC_R = 0, PC_K = 512, PC_V = 1024, PC_ZW = 1536, PC_ZA = 1600, PC_G = 1664, PC_PAD = 2176, PC_SQ = 2304, PC_SK = 2816, PC_SV = 3328, PC_SG = 3840;
constexpr int IN_COLS = 4224, SHIFT_COLS = 1664, NCHUNK = SEQ / 64;
constexpr size_t MiB = 1u << 20;
constexpr size_t WS_MODP = 0, WS_GATE = 786432, WS_W2T = 1 * MiB, WS_A2T = WS_W2T + 131072, WS_WIN = 2 * MiB, WS_WOUT = 19 * MiB, WS_GAM = 23 * MiB,
                 WS_H = 24 * MiB, WS_P = 56 * MiB, WS_D = 192 * MiB, WS_END = 256 * MiB;
constexpr int LDS_BYTES = 159744;
constexpr int NPHASE = 14;

struct Args { const float* in[19]; float* out; unsigned char* ws; int ph_lo, ph_hi; };

__device__ __forceinline__ unsigned f2bf(float f) { unsigned u = __builtin_bit_cast(unsigned, f); return (u + 0x7fffu + ((u >> 16) & 1u)) >> 16; }
__device__ __forceinline__ float bf2f(unsigned u) { return __builtin_bit_cast(float, u << 16); }
__device__ __forceinline__ unsigned pk2(float lo, float hi) { return pg8::cvt_pk_bf16(lo, hi); }
__device__ __forceinline__ f32x4 mfma16(bf16x8 a, bf16x8 b, f32x4 c) { return __builtin_amdgcn_mfma_f32_16x16x32_bf16(a, b, c, 0, 0, 0); }
__device__ __forceinline__ void unpack8(u32x4 w, float* o) {
    o[0] = bf2f(w.x & 0xffffu); o[1] = __builtin_bit_cast(float, w.x & 0xffff0000u); o[2] = bf2f(w.y & 0xffffu); o[3] = __builtin_bit_cast(float, w.y & 0xffff0000u);
    o[4] = bf2f(w.z & 0xffffu); o[5] = __builtin_bit_cast(float, w.z & 0xffff0000u); o[6] = bf2f(w.w & 0xffffu); o[7] = __builtin_bit_cast(float, w.w & 0xffff0000u); }
__device__ __forceinline__ f32x4 unpack4(u32x2 w) { f32x4 o; o[0] = bf2f(w.x & 0xffffu); o[1] = __builtin_bit_cast(float, w.x & 0xffff0000u); o[2] = bf2f(w.y & 0xffffu); o[3] = __builtin_bit_cast(float, w.y & 0xffff0000u); return o; }
__device__ __forceinline__ u32x2 pack4(f32x4 v) { u32x2 w; w.x = pk2(v[0], v[1]); w.y = pk2(v[2], v[3]); return w; }
__device__ __forceinline__ bf16x8 pack8(f32x4 a, f32x4 b) { u32x4 w; w.x = pk2(a[0], a[1]); w.y = pk2(a[2], a[3]); w.z = pk2(b[0], b[1]); w.w = pk2(b[2], b[3]); return __builtin_bit_cast(bf16x8, w); }
__device__ __forceinline__ float wave_sum(float v) {
#pragma unroll
    for (int o = 1; o < 64; o <<= 1) v += __shfl_xor(v, o);
    return v; }
#define WG_BAR() do { asm volatile("s_waitcnt vmcnt(0) lgkmcnt(0)" ::: "memory"); __builtin_amdgcn_s_barrier(); asm volatile("" ::: "memory"); } while (0)
#define LDS_BAR() do { asm volatile("s_waitcnt lgkmcnt(0)" ::: "memory"); __builtin_amdgcn_s_barrier(); asm volatile("" ::: "memory"); } while (0)
__device__ __forceinline__ f32x4 tile64(ldsp A, int arow, ldsp B, int brow, int q, f32x4 acc) {
#pragma unroll
    for (int ks = 0; ks < 2; ++ks) { const bf16x8 a = *(LAS const bf16x8*)(A + arow * 144 + ks * 64 + q * 16), b = *(LAS const bf16x8*)(B + brow * 144 + ks * 64 + q * 16); acc = mfma16(a, b, acc); }
    return acc; }

__device__ __forceinline__ void p0_transpose_item(const float* W, int K, int N, int src_n0, bf16_t* WT, int dst_n0, int k0, LAS float* scr, int lane) {
#pragma unroll 8
    for (int i = 0; i < 32; ++i) { const int kk = 2 * i + (lane >> 5); scr[kk * 33 + (lane & 31)] = src_n0 >= 0 ? W[(size_t)(k0 + kk) * N + src_n0 + (lane & 31)] : 0.f; }
    asm volatile("s_waitcnt lgkmcnt(0)" ::: "memory");
    const int c = lane & 7;
#pragma unroll
    for (int j = 0; j < 4; ++j) { const int n = (lane >> 3) + 8 * j; const LAS float* s = scr + (8 * c) * 33 + n;
        u32x4 o; o.x = pk2(s[0 * 33], s[1 * 33]); o.y = pk2(s[2 * 33], s[3 * 33]); o.z = pk2(s[4 * 33], s[5 * 33]); o.w = pk2(s[6 * 33], s[7 * 33]);
        *(u32x4*)(WT + (size_t)(dst_n0 + n) * K + k0 + 8 * c) = o; }
    asm volatile("s_waitcnt lgkmcnt(0)" ::: "memory");
}
__device__ __forceinline__ void phase_p0(const Args& a, ldsp lds, int tid, int lane, int wave, int G) {
    unsigned char* ws = a.ws;
    LAS float* scr = (LAS float*)(lds + wave * 16384);
    const int gw = blockIdx.x * 8 + wave, NGW = G * 8;
    constexpr int I_IN = 16 * (NPC / 32), I_OUT = 16 * (DM / 32), NITEMS = 2 * I_IN + 2 * I_OUT;
    for (int it = gw; it < NITEMS; it += NGW) {
        int r = it;
        if (r < 2 * I_IN) { const int l = r / I_IN; r -= l * I_IN; const int kb = r / (NPC / 32), nb = r % (NPC / 32); const int dn = 32 * nb;
            const int sn = dn < PC_PAD ? dn : (dn < PC_SQ ? -1 : dn - 128);
            p0_transpose_item(a.in[5] + (size_t)l * DM * IN_COLS, DM, IN_COLS, sn, (bf16_t*)(ws + WS_WIN) + (size_t)l * NPC * DM, dn, 64 * kb, scr, lane); }
        else { r -= 2 * I_IN; const int l = r / I_OUT; r -= l * I_OUT; const int kb = r / (DM / 32), nb = r % (DM / 32);
            p0_transpose_item(a.in[6] + (size_t)l * DM * DM, DM, DM, 32 * nb, (bf16_t*)(ws + WS_WOUT) + (size_t)l * DM * DM, 32 * nb, 64 * kb, scr, lane); }
    }
    { const int gt = blockIdx.x * 512 + tid, NT = G * 512;
      for (int o = gt; o < 2 * 65536; o += NT) { const int which = o >> 16, rem = o & 65535, l = rem >> 15, r2 = rem & 32767, n = r2 >> 6, m = r2 & 63;
          const float v = a.in[which ? 11 : 9][(size_t)(l * 64 + m) * 512 + n];
          ((bf16_t*)(ws + (which ? WS_A2T : WS_W2T)))[rem] = (bf16_t)f2bf(v); } }
    WG_BAR();
    LAS float* red = (LAS float*)lds;
    for (int unit = blockIdx.x; unit < 384; unit += G) {
        const int l = unit / 192, r = unit % 192, kp = r / 12, ncb = r % 12;
        const int n = ncb * 256 + (tid & 255), kh = tid >> 8, kbeg = kp * 64 + kh * 32;
        const float* W = a.in[3] + (size_t)l * DM * 3072 + n; const float* c0 = a.in[1]; const float* c1 = a.in[1] + DM;
        float a0 = 0.f, a1 = 0.f;
#pragma unroll 8
        for (int k = kbeg; k < kbeg + 32; ++k) { const float w = W[(size_t)k * 3072]; const float x0 = c0[k], x1 = c1[k];
            a0 += x0 / (1.f + __expf(-x0)) * w; a1 += x1 / (1.f + __expf(-x1)) * w; }
        if (kh == 1) { red[tid & 255] = a0; red[256 + (tid & 255)] = a1; }
        LDS_BAR();
        if (kh == 0) { float* mp = (float*)(ws + WS_MODP) + (size_t)((l * 16 + kp) * 2) * 3072 + n; mp[0] = a0 + red[tid]; mp[3072] = a1 + red[256 + tid]; }
        LDS_BAR();
    }
}

__device__ __forceinline__ void phase_h(const Args& a, ldsp lds, int l, const float* xin, int tid, int lane, int wave, int G) {
    unsigned char* ws = a.ws;
    LAS float* sc = (LAS float*)lds; LAS float* sh = sc + 2048;
    const float* modp = (const float*)(ws + WS_MODP) + (size_t)l * 16 * 2 * 3072; const float* adab = a.in[4] + l * 3072; const float* ng = a.in[2] + l * DM;
    for (int idx = tid; idx < 2048; idx += 512) { const int b = idx >> 10, k = idx & 1023; float s0 = adab[k], s1 = adab[1024 + k], s2 = adab[2048 + k];
        for (int kp = 0; kp < 16; ++kp) { const float* mp = modp + (size_t)(kp * 2 + b) * 3072; s0 += mp[k]; s1 += mp[1024 + k]; s2 += mp[2048 + k]; }
        sh[idx] = s0; sc[idx] = ng[k] * (1.f + s1);
        if (blockIdx.x == 0) ((float*)(ws + WS_GATE))[(l * 2 + b) * 1024 + k] = s2; }
    LDS_BAR();
    bf16_t* H = (bf16_t*)(ws + WS_H);
    const int gw = blockIdx.x * 8 + wave, NGW = G * 8;
    for (int m = gw; m < MROWS; m += NGW) {
        const f32x4* xr = (const f32x4*)(xin + (size_t)m * DM) + lane; const int b = m >> 13;
        f32x4 v[4]; float s = 0.f;
#pragma unroll
        for (int j = 0; j < 4; ++j) { v[j] = xr[64 * j]; s += (v[j][0] * v[j][0] + v[j][1] * v[j][1]) + (v[j][2] * v[j][2] + v[j][3] * v[j][3]); }
        const float rstd = 1.0f / sqrtf(wave_sum(s) * (1.f / DM) + 1e-6f);
        unsigned long long* o8 = (unsigned long long*)(H + (size_t)m * DM) + lane;
#pragma unroll
        for (int j = 0; j < 4; ++j) { const int k = 4 * lane + 256 * j; const f32x4 scv = *(LAS const f32x4*)(sc + b * 1024 + k), shv = *(LAS const f32x4*)(sh + b * 1024 + k);
            const f32x4 hv = v[j] * rstd * scv + shv; o8[64 * j] = (unsigned long long)pk2(hv[0], hv[1]) | ((unsigned long long)pk2(hv[2], hv[3]) << 32); }
    }
}
constexpr int L_RS = 0, L_KS = 16384, L_PB = 0, L_PTB = 9216, L_TB = 18432, L_TZW = 32768, L_ZA = 32768 + 9216, L_XT = 32768, L_C = 32768 + 18432;
constexpr int L_AG = L_C, L_RG = L_C + 9216, L_BG = L_C + 2 * 9216, L_KG = L_C + 3 * 9216, L_AGT = L_C + 4 * 9216, L_BTT = L_C + 5 * 9216, L_KTT = L_C + 6 * 9216, L_VT = L_C + 7 * 9216;
constexpr int L_D = L_C + 8 * 9216, L_AAK = L_D, L_ARB = L_D + 9216, L_ARK = L_D + 2 * 9216, L_MISC = L_D + 3 * 9216, L_AKVT = L_BG;
static_assert(L_MISC + 2048 <= LDS_BYTES, "R1 LDS map");
__device__ __forceinline__ float tanh_f(float x) { return 1.f - 2.f / (__expf(2.f * x) + 1.f); }
__device__ __forceinline__ void st16(ldsp p, float v) { *(LAS bf16_t*)p = (bf16_t)f2bf(v); }

#ifdef DBG_CHECK
constexpr size_t WS_DBG = 23 * MiB + 512 * 1024;
constexpr size_t WS_DUMP = WS_DBG + 256 * 1024;
__device__ __forceinline__ void dbg_dump(unsigned char* ws, ldsp lds, int l, int u, int tid, int ldsoff, int bytes, int dstoff) {
    if (l == 0 && u == 0) { for (int i = tid * 4; i < bytes; i += 2048) *(unsigned*)(ws + WS_DUMP + dstoff + i) = *(LAS const unsigned*)(lds + ldsoff + i); }
}
#define DBG_DUMP(ldsoff, bytes, dstoff) dbg_dump(ws, lds, l, u, tid, ldsoff, bytes, dstoff)
#else
#define DBG_DUMP(ldsoff, bytes, dstoff) do { } while (0)
#endif
__device__ __forceinline__ void r1_unit(const Args& a, ldsp lds, int l, int u, int tid, int lane, int wave) {
    unsigned char* ws = a.ws;
    const int b = u >> 10, h = (u >> 7) & 7, c = u & 127, row0 = b * SEQ + c * 64, l15 = lane & 15, q = lane >> 4;
    bf16_t* P = (bf16_t*)(ws + WS_P);
    LAS float* RS = (LAS float*)(lds + L_RS); LAS float* KS = (LAS float*)(lds + L_KS);
    LAS float* rnorm = (LAS float*)(lds + L_MISC); LAS float* bonp = rnorm + 64;
    {
        const int tt = tid >> 3, part = tid & 7; const int row = row0 + tt; const bool hasprev = !(c == 0 && tt == 0);
        const bf16_t* prow = P + (size_t)row * NPC; const bf16_t* pprev = prow - NPC; const float* mu = a.in[7] + l * SHIFT_COLS;
        float cur[8], prv[8], ps[8];
#define R1_SHIFT(col) do { unpack8(*(const u32x4*)(prow + (col)), cur); if (hasprev) unpack8(*(const u32x4*)(pprev + (col)), prv); else { _Pragma("unroll") for (int e = 0; e < 8; ++e) prv[e] = 0.f; } \
        const f32x4 m0 = *(const f32x4*)(mu + (col)), m1 = *(const f32x4*)(mu + (col) + 4); \
        _Pragma("unroll") for (int e = 0; e < 4; ++e) { ps[e] = cur[e] + (prv[e] - cur[e]) * m0[e]; ps[4 + e] = cur[4 + e] + (prv[4 + e] - cur[4 + e]) * m1[e]; } } while (0)
        R1_SHIFT(PC_R + h * 64 + part * 8);
        *(LAS f32x4*)(RS + tt * 64 + part * 8) = (f32x4){ps[0], ps[1], ps[2], ps[3]}; *(LAS f32x4*)(RS + tt * 64 + part * 8 + 4) = (f32x4){ps[4], ps[5], ps[6], ps[7]};
        R1_SHIFT(PC_K + h * 64 + part * 8);
        *(LAS f32x4*)(KS + tt * 64 + part * 8) = (f32x4){ps[0], ps[1], ps[2], ps[3]}; *(LAS f32x4*)(KS + tt * 64 + part * 8 + 4) = (f32x4){ps[4], ps[5], ps[6], ps[7]};
        { const float* kkp = a.in[12] + l * RWW + h * 64 + part * 8; float ss = 0.f;
#pragma unroll
          for (int e = 0; e < 8; ++e) { const float t = ps[e] * kkp[e]; ss += t * t; }
          ss += __shfl_xor(ss, 1); ss += __shfl_xor(ss, 2); ss += __shfl_xor(ss, 4);
          if (part == 0) rnorm[tt] = 1.0f / sqrtf(fmaxf(ss, 1e-24f)); }
        R1_SHIFT(PC_V + h * 64 + part * 8);
#pragma unroll
        for (int e = 0; e < 8; ++e) st16(lds + L_VT + (part * 8 + e) * 144 + tt * 2, ps[e]);
        R1_SHIFT(PC_ZW + part * 8);
        { u32x4 w; w.x = pk2(tanh_f(ps[0]), tanh_f(ps[1])); w.y = pk2(tanh_f(ps[2]), tanh_f(ps[3])); w.z = pk2(tanh_f(ps[4]), tanh_f(ps[5])); w.w = pk2(tanh_f(ps[6]), tanh_f(ps[7]));
          *(LAS u32x4*)(lds + L_TZW + tt * 144 + part * 16) = w; }
        R1_SHIFT(PC_ZA + part * 8);
        { u32x4 w; w.x = pk2(ps[0], ps[1]); w.y = pk2(ps[2], ps[3]); w.z = pk2(ps[4], ps[5]); w.w = pk2(ps[6], ps[7]); *(LAS u32x4*)(lds + L_ZA + tt * 144 + part * 16) = w; }
#undef R1_SHIFT
    }
    LDS_BAR();
    if (wave < 4) {
        const int jl = 16 * wave + l15, jg = h * 64 + jl;
        f32x4 wacc[4], aacc[4];
        { const bf16_t* w2t = (const bf16_t*)(ws + WS_W2T) + ((size_t)l * 512 + jg) * 64; const bf16_t* a2t = (const bf16_t*)(ws + WS_A2T) + ((size_t)l * 512 + jg) * 64;
          bf16x8 bw[2], ba[2];
#pragma unroll
          for (int ks = 0; ks < 2; ++ks) { bw[ks] = *(const bf16x8*)(w2t + 32 * ks + 8 * q); ba[ks] = *(const bf16x8*)(a2t + 32 * ks + 8 * q); }
#pragma unroll
          for (int mt = 0; mt < 4; ++mt) { wacc[mt] = (f32x4){0.f, 0.f, 0.f, 0.f}; aacc[mt] = (f32x4){0.f, 0.f, 0.f, 0.f};
#pragma unroll
              for (int ks = 0; ks < 2; ++ks) { const bf16x8 a1 = *(LAS const bf16x8*)(lds + L_TZW + (16 * mt + l15) * 144 + ks * 64 + q * 16), a2 = *(LAS const bf16x8*)(lds + L_ZA + (16 * mt + l15) * 144 + ks * 64 + q * 16);
                  wacc[mt] = mfma16(a1, bw[ks], wacc[mt]); aacc[mt] = mfma16(a2, ba[ks], aacc[mt]); } } }
        const float w0v = a.in[8][l * RWW + jg], a0v = a.in[10][l * RWW + jg], kkv = a.in[12][l * RWW + jg], kav = a.in[13][l * RWW + jg], rkv = a.in[14][l * RWW + jg];
        f32x4 ldv[4], cin[4]; float carry = 0.f;
#pragma unroll
        for (int mt = 0; mt < 4; ++mt) {
#pragma unroll
            for (int r = 0; r < 4; ++r) { const float wa = w0v + wacc[mt][r]; const float sp = fmaxf(-wa, 0.f) + __logf(1.f + __expf(-fabsf(wa)));
                ldv[mt][r] = -__expf(-sp - 0.5f);
                aacc[mt][r] = 1.f / (1.f + __expf(-(a0v + aacc[mt][r]))); }
            const float p0 = ldv[mt][0], p1 = p0 + ldv[mt][1], p2 = p1 + ldv[mt][2], p3 = p2 + ldv[mt][3];
            const float t0 = __shfl(p3, l15), t1 = __shfl(p3, l15 + 16), t2 = __shfl(p3, l15 + 32), t3 = __shfl(p3, l15 + 48);
            const float base = carry + (q > 0 ? t0 : 0.f) + (q > 1 ? t1 : 0.f) + (q > 2 ? t2 : 0.f);
            cin[mt] = (f32x4){base + p0, base + p1, base + p2, base + p3}; carry += (t0 + t1) + (t2 + t3);
        }
        const float ctot = carry;
#pragma unroll
        for (int mt = 0; mt < 4; ++mt) { f32x4 agt, btt, ktt;
#pragma unroll
            for (int r = 0; r < 4; ++r) { const int t = 16 * mt + 4 * q + r; const float rr = RS[t * 64 + jl], kr = KS[t * 64 + jl], rn = rnorm[t];
                const float kk = kr * kkv * rn, av = aacc[mt][r], bq = kk * av, kp = kr * (1.f + (av - 1.f) * kav);
                const float ci = cin[mt][r], e_in = __expf(ci), e_ex = __expf(ci - ldv[mt][r]), e_ni = __expf(-ci), e_t = __expf(ctot - ci);
                const float Ag = -kk * e_ex, Rg = rr * e_in, Bg = bq * e_ni, Kg = kp * e_ni; agt[r] = Ag; btt[r] = bq * e_t; ktt[r] = kp * e_t;
                st16(lds + L_AG + t * 144 + jl * 2, Ag); st16(lds + L_RG + t * 144 + jl * 2, Rg); st16(lds + L_BG + t * 144 + jl * 2, Bg); st16(lds + L_KG + t * 144 + jl * 2, Kg);
                float bon = rr * kp * rkv; bon += __shfl_xor(bon, 1); bon += __shfl_xor(bon, 2); bon += __shfl_xor(bon, 4); bon += __shfl_xor(bon, 8);
                if (l15 == 0) bonp[wave * 64 + t] = bon; }
            *(LAS u32x2*)(lds + L_AGT + jl * 144 + (16 * mt + 4 * q) * 2) = pack4(agt); *(LAS u32x2*)(lds + L_BTT + jl * 144 + (16 * mt + 4 * q) * 2) = pack4(btt);
            *(LAS u32x2*)(lds + L_KTT + jl * 144 + (16 * mt + 4 * q) * 2) = pack4(ktt); }
        if (q == 0) ((float*)(ws + WS_GAM))[(size_t)u * 64 + jl] = __expf(ctot);
    }
    LDS_BAR();
    DBG_DUMP(L_C, 73728, 0);
    if (tid < 64) { const float bs = (bonp[tid] + bonp[64 + tid]) + (bonp[128 + tid] + bonp[192 + tid]); *(float*)((unsigned char*)(P + (size_t)(row0 + tid) * NPC + PC_PAD) + h * 4) = bs; }
    { const int blk = wave & 3, half = wave >> 2; const int aoff = (blk & 1) ? L_KG : L_BG, boff = (blk & 2) ? L_RG : L_AG;
      const int dest = blk == 0 ? L_PB : (blk == 1 ? L_AAK : (blk == 2 ? L_ARB : L_ARK));
#pragma unroll 1
      for (int i = 0; i < 8; ++i) { const int ti = 2 * i + half, mt = ti >> 2, nt = ti & 3; f32x4 acc = (f32x4){0.f, 0.f, 0.f, 0.f};
          if (mt <= nt) acc = tile64(lds + aoff, 16 * mt + l15, lds + boff, 16 * nt + l15, q, acc);
          const int t = 16 * nt + l15, tb = 16 * mt + 4 * q;
#pragma unroll
          for (int r = 0; r < 4; ++r) { const bool keep = (blk < 2) ? (tb + r < t) : (tb + r <= t); acc[r] = keep ? acc[r] : 0.f; }
          *(LAS u32x2*)(lds + dest + t * 144 + tb * 2) = pack4(acc);
          if (blk == 0) {
#pragma unroll
              for (int r = 0; r < 4; ++r) st16(lds + L_PTB + (tb + r) * 144 + t * 2, acc[r]); } } }
    LDS_BAR();
    DBG_DUMP(L_PB, 18432, 73728); DBG_DUMP(L_D, 27648, 73728 + 18432);
#pragma unroll
    for (int i = 0; i < 2; ++i) { const int id = wave * 2 + i, mt = id >> 2, nt = id & 3; f32x4 acc = (f32x4){0.f, 0.f, 0.f, 0.f};
        acc = tile64(lds + L_AAK, 16 * mt + l15, lds + L_VT, 16 * nt + l15, q, acc);
        *(LAS u32x2*)(lds + L_AKVT + (16 * nt + l15) * 144 + (16 * mt + 4 * q) * 2) = pack4(acc); }
#ifdef DBG_CHECK
    LDS_BAR(); DBG_DUMP(L_AKVT, 9216, -49152); LDS_BAR();
#endif
    { const int mt = wave >> 1; f32x4 Tacc[2], Pn[2];
#pragma unroll
      for (int i = 0; i < 2; ++i) { const int nt = 2 * (wave & 1) + i, tau = 16 * nt + l15;
#pragma unroll
          for (int r = 0; r < 4; ++r) { const int t = 16 * mt + 4 * q + r; Tacc[i][r] = bf2f(*(LAS const bf16_t*)(lds + L_PB + t * 144 + tau * 2)) + (t == tau ? 1.f : 0.f); } }
      for (int round = 0; round < 5; ++round) {
#pragma unroll
          for (int i = 0; i < 2; ++i) { const int nt = 2 * (wave & 1) + i; Pn[i] = (f32x4){0.f, 0.f, 0.f, 0.f};
              if (nt <= mt) Pn[i] = tile64(lds + L_PB, 16 * mt + l15, lds + L_PTB, 16 * nt + l15, q, Pn[i]); }
          LDS_BAR();
#pragma unroll
          for (int i = 0; i < 2; ++i) { const int nt = 2 * (wave & 1) + i, tau = 16 * nt + l15;
#pragma unroll
              for (int r = 0; r < 4; ++r) { const int t = 16 * mt + 4 * q + r; st16(lds + L_PB + t * 144 + tau * 2, Pn[i][r]); st16(lds + L_TB + t * 144 + tau * 2, Tacc[i][r]); }
              *(LAS u32x2*)(lds + L_PTB + tau * 144 + (16 * mt + 4 * q) * 2) = pack4(Pn[i]); }
          LDS_BAR();
#pragma unroll
          for (int i = 0; i < 2; ++i) { const int nt = 2 * (wave & 1) + i; if (nt <= mt) Tacc[i] = tile64(lds + L_TB, 16 * mt + l15, lds + L_PTB, 16 * nt + l15, q, Tacc[i]); }
      }
      LDS_BAR();
#pragma unroll
      for (int i = 0; i < 2; ++i) { const int nt = 2 * (wave & 1) + i, tau = 16 * nt + l15;
#pragma unroll
          for (int r = 0; r < 4; ++r) { const int t = 16 * mt + 4 * q + r; st16(lds + L_TB + t * 144 + tau * 2, Tacc[i][r]); } }
    }
    LDS_BAR();
    DBG_DUMP(L_TB, 9216, 119808); DBG_DUMP(L_AKVT, 9216, 129024);
#pragma unroll 1
    for (int i = 0; i < 4; ++i) { const int id = wave * 4 + i, mt = id & 3, nt = id >> 2; f32x4 acc = (f32x4){0.f, 0.f, 0.f, 0.f};
        acc = tile64(lds + L_TB, 16 * mt + l15, nt < 4 ? lds + L_AGT : lds + L_AKVT, 16 * (nt & 3) + l15, q, acc);
        *(LAS u32x2*)(lds + L_XT + (16 * nt + l15) * 144 + (16 * mt + 4 * q) * 2) = pack4(acc); }
    LDS_BAR();
    DBG_DUMP(L_XT, 18432, 138240);
    { unsigned char* Du = ws + WS_D + (size_t)u * 32768; const int kind = wave >> 1;
#pragma unroll 1
      for (int i = 0; i < 8; ++i) { const int id = (wave & 1) * 8 + i, mt = id & 3, nt = id >> 2; f32x4 acc = (f32x4){0.f, 0.f, 0.f, 0.f}; const int row = 16 * nt + l15;
          if (kind == 0) { acc = tile64(lds + L_XT, 16 * mt + l15, lds + L_BTT, row, q, acc); }
          else if (kind == 1) { acc = tile64(lds + L_XT, 16 * mt + l15, lds + L_ARB, row, q, acc); acc += unpack4(*(LAS const u32x2*)(lds + L_RG + row * 144 + (16 * mt + 4 * q) * 2)); }
          else if (kind == 2) { acc = tile64(lds + L_BTT, 16 * mt + l15, lds + L_XT, 64 + row, q, acc); acc = tile64(lds + L_KTT, 16 * mt + l15, lds + L_VT, row, q, acc); }
          else { acc = tile64(lds + L_ARB, 16 * mt + l15, lds + L_XT, 64 + row, q, acc); acc = tile64(lds + L_ARK, 16 * mt + l15, lds + L_VT, row, q, acc); }
          const int sw = (row >> 1) & 7;
          const int off = kind < 2 ? row * 128 + (((4 * (mt >> 1) + q) ^ sw) * 16) + 8 * (mt & 1) : row * 128 + (((2 * mt + (q >> 1)) ^ sw) * 16) + 8 * (q & 1);
          *(u32x2*)(Du + kind * 8192 + off) = pack4(acc); } }
    LDS_BAR();
}

__device__ __forceinline__ void sb_task(const Args& a, ldsp vs, int l, int task, int lane) {
    unsigned char* ws = a.ws; const bf16_t* P = (const bf16_t*)(ws + WS_P); bf16_t* Y = (bf16_t*)(ws + WS_H);
    const int bh = task >> 9, qt = task & 511, b = bh >> 3, h = bh & 7, q0 = qt * 16, rowb = b * SEQ, l15 = lane & 15, q = lane >> 4;
    bf16x8 bq[2];
#pragma unroll
    for (int ks = 0; ks < 2; ++ks) bq[ks] = *(const bf16x8*)(P + (size_t)(rowb + q0 + l15) * NPC + PC_SQ + h * 64 + 32 * ks + 8 * q);
    bf16x8 am[2];
#pragma unroll
    for (int mt = 0; mt < 2; ++mt)
#pragma unroll
        for (int e = 0; e < 8; ++e) am[mt][e] = ((16 * (e >> 2) + 4 * q + (e & 3)) > (16 * mt + l15)) ? (short)0x3F80 : (short)0;
    f32x4 O[4];
#pragma unroll
    for (int nt = 0; nt < 4; ++nt) O[nt] = (f32x4){0.f, 0.f, 0.f, 0.f};
    float carry = 0.f; const int t = q0 + l15;
    int kb = (q0 + 14) >> 5;
    bf16x8 kA[2][2], kN[2][2]; u32x4 vR[4], vN[4];
#define SB_LOAD(KA, VR, kbv) do { _Pragma("unroll") for (int mt = 0; mt < 2; ++mt) _Pragma("unroll") for (int ks = 0; ks < 2; ++ks) \
        KA[mt][ks] = *(const bf16x8*)(P + (size_t)(rowb + 32 * (kbv) + 16 * mt + l15) * NPC + PC_SK + h * 64 + 32 * ks + 8 * q); \
        _Pragma("unroll") for (int i = 0; i < 4; ++i) { const int pi = lane + 64 * i; VR[i] = *(const u32x4*)(P + (size_t)(rowb + 32 * (kbv) + (pi >> 3)) * NPC + PC_SV + h * 64 + (pi & 7) * 8); } } while (0)
    SB_LOAD(kA, vR, kb);
    for (;;) {
#pragma unroll
        for (int i = 0; i < 4; ++i) { const int pi = lane + 64 * i; *(LAS u32x4*)(vs + (pi >> 3) * 144 + (pi & 7) * 16) = vR[i]; }
        if (kb > 0) SB_LOAD(kN, vN, kb - 1);
        f32x4 ell[2], lsz[2]; bool valid[2][4];
#pragma unroll
        for (int mt = 0; mt < 2; ++mt) { f32x4 z = (f32x4){0.f, 0.f, 0.f, 0.f}; z = mfma16(kA[mt][0], bq[0], z); z = mfma16(kA[mt][1], bq[1], z);
#pragma unroll
            for (int r = 0; r < 4; ++r) { const int s = 32 * kb + 16 * mt + 4 * q + r; const float zz = z[r] * 0.125f; const float sp = fmaxf(zz, 0.f) + __logf(1.f + __expf(-fabsf(zz)));
                valid[mt][r] = s < t; ell[mt][r] = valid[mt][r] ? -sp : 0.f; lsz[mt][r] = zz - sp; } }
        const bf16x8 Lhi = pack8(ell[0], ell[1]);
        f32x4 lo0, lo1; { const u32x4 w = __builtin_bit_cast(u32x4, Lhi);
            lo0[0] = ell[0][0] - bf2f(w.x & 0xffffu); lo0[1] = ell[0][1] - __builtin_bit_cast(float, w.x & 0xffff0000u); lo0[2] = ell[0][2] - bf2f(w.y & 0xffffu); lo0[3] = ell[0][3] - __builtin_bit_cast(float, w.y & 0xffff0000u);
            lo1[0] = ell[1][0] - bf2f(w.z & 0xffffu); lo1[1] = ell[1][1] - __builtin_bit_cast(float, w.z & 0xffff0000u); lo1[2] = ell[1][2] - bf2f(w.w & 0xffffu); lo1[3] = ell[1][3] - __builtin_bit_cast(float, w.w & 0xffff0000u); }
        const bf16x8 Llo = pack8(lo0, lo1);
        f32x4 aft[2], wv[2];
#pragma unroll
        for (int mt = 0; mt < 2; ++mt) { aft[mt] = (f32x4){0.f, 0.f, 0.f, 0.f}; aft[mt] = mfma16(am[mt], Lhi, aft[mt]); aft[mt] = mfma16(am[mt], Llo, aft[mt]);
#pragma unroll
            for (int r = 0; r < 4; ++r) wv[mt][r] = valid[mt][r] ? __expf(lsz[mt][r] + aft[mt][r] + carry) : 0.f; }
        carry += __shfl(aft[0][0] + ell[0][0], l15);
        const bf16x8 Wop = pack8(wv[0], wv[1]);
        asm volatile("s_waitcnt lgkmcnt(0)" ::: "memory");
#pragma unroll
        for (int nt = 0; nt < 4; ++nt) { bf16x8 vb;
#pragma unroll
            for (int e = 0; e < 8; ++e) vb[e] = (short)*(LAS const bf16_t*)(vs + (16 * (e >> 2) + 4 * q + (e & 3)) * 144 + (16 * nt + l15) * 2);
            O[nt] = mfma16(Wop, vb, O[nt]); }
        if (kb == 0) break;
        if (__all(carry < -100.f)) break;
        --kb;
#pragma unroll
        for (int mt = 0; mt < 2; ++mt)
#pragma unroll
            for (int ks = 0; ks < 2; ++ks) kA[mt][ks] = kN[mt][ks];
#pragma unroll
        for (int i = 0; i < 4; ++i) vR[i] = vN[i];
    }
#undef SB_LOAD
    const float* sbg = a.in[17] + l * 512 + h * 64;
#pragma unroll
    for (int r = 0; r < 4; ++r) { float ss = (O[0][r] * O[0][r] + O[1][r] * O[1][r]) + (O[2][r] * O[2][r] + O[3][r] * O[3][r]);
        ss += __shfl_xor(ss, 1); ss += __shfl_xor(ss, 2); ss += __shfl_xor(ss, 4); ss += __shfl_xor(ss, 8);
        const float rms = 1.0f / sqrtf(ss * (1.f / 64.f) + 1e-6f); const int tq = q0 + 4 * q + r;
        const size_t row = (size_t)(rowb + ((tq & 127) << 6) + (tq >> 7));
#pragma unroll
        for (int nt = 0; nt < 4; ++nt) { const int d = 16 * nt + l15; const float g = bf2f(P[row * NPC + PC_SG + h * 64 + d]);
            float yv = O[nt][r] * rms * sbg[d] * (g / (1.f + __expf(-g)));
#ifdef DBG_ZERO_SB
            yv = 0.f;
#endif
            Y[row * DM + 512 + h * 64 + d] = (bf16_t)f2bf(yv); } }
}
constexpr int R2_SLOT = 10496, R2_NS = 12, R2_PD = 10;
__device__ __forceinline__ void phase_r2(const Args& a, ldsp lds, int tid, int lane, int wave) {
    unsigned char* ws = a.ws; const int bh = blockIdx.x >> 2, ig = blockIdx.x & 3, b = bh >> 3, h = bh & 7, u0 = bh * NCHUNK, l15 = lane & 15, q = lane >> 4;
    const unsigned char* Dg = ws + WS_D + (size_t)u0 * 32768; const unsigned char* Gg = ws + WS_GAM + (size_t)u0 * 256;
    if (wave == 1) {
#define R2_ISSUE_A(cc) do { const int c_ = (cc) < NCHUNK ? (cc) : NCHUNK - 1; const int sl_ = ((cc) % R2_NS) * R2_SLOT; _Pragma("unroll") for (int i = 0; i < 6; ++i) \
        __builtin_amdgcn_global_load_lds((const unsigned*)(Dg + (size_t)c_ * 32768 + i * 1024 + lane * 16), (LAS unsigned*)(lds + sl_ + i * 1024), 16, 0, 0); } while (0)
        for (int c = 0; c < R2_PD; ++c) R2_ISSUE_A(c);
        asm volatile("s_waitcnt vmcnt(54)" ::: "memory");
        __builtin_amdgcn_s_barrier();
        for (int c = 0; c < NCHUNK; ++c) { R2_ISSUE_A(c + R2_PD); asm volatile("s_waitcnt vmcnt(54)" ::: "memory"); __builtin_amdgcn_s_barrier(); }
        asm volatile("s_waitcnt vmcnt(0)" ::: "memory");
#undef R2_ISSUE_A
    } else if (wave == 2) {
#define R2_ISSUE_B(cc) do { const int c_ = (cc) < NCHUNK ? (cc) : NCHUNK - 1; const int sl_ = ((cc) % R2_NS) * R2_SLOT; const unsigned char* du_ = Dg + (size_t)c_ * 32768; \
        __builtin_amdgcn_global_load_lds((const unsigned*)(du_ + 6 * 1024 + lane * 16), (LAS unsigned*)(lds + sl_ + 6 * 1024), 16, 0, 0); \
        __builtin_amdgcn_global_load_lds((const unsigned*)(du_ + 7 * 1024 + lane * 16), (LAS unsigned*)(lds + sl_ + 7 * 1024), 16, 0, 0); \
        __builtin_amdgcn_global_load_lds((const unsigned*)(du_ + 16384 + ig * 2048 + lane * 16), (LAS unsigned*)(lds + sl_ + 8192), 16, 0, 0); \
        __builtin_amdgcn_global_load_lds((const unsigned*)(du_ + 16384 + ig * 2048 + 1024 + lane * 16), (LAS unsigned*)(lds + sl_ + 9216), 16, 0, 0); \
        if (lane < 16) __builtin_amdgcn_global_load_lds((const unsigned*)(Gg + (size_t)c_ * 256 + lane * 16), (LAS unsigned*)(lds + sl_ + 10240), 16, 0, 0); } while (0)
        for (int c = 0; c < R2_PD; ++c) R2_ISSUE_B(c);
        asm volatile("s_waitcnt vmcnt(45)" ::: "memory");
        __builtin_amdgcn_s_barrier();
        for (int c = 0; c < NCHUNK; ++c) { R2_ISSUE_B(c + R2_PD); asm volatile("s_waitcnt vmcnt(45)" ::: "memory"); __builtin_amdgcn_s_barrier(); }
        asm volatile("s_waitcnt vmcnt(0)" ::: "memory");
#undef R2_ISSUE_B
    } else if (wave == 0) {
        const int swi = (l15 >> 1) & 7;
        unsigned char* sg = ws + WS_P + (size_t)(b * SEQ + 16 * ig + l15) * (NPC * 2) + h * 128 + 16 * q;
        f32x4 S[4];
#pragma unroll
        for (int mt = 0; mt < 4; ++mt) S[mt] = (f32x4){0.f, 0.f, 0.f, 0.f};
        asm volatile("" ::: "memory"); __builtin_amdgcn_s_barrier(); asm volatile("" ::: "memory");
        for (int c = 0; c < NCHUNK; ++c) {
            ldsp slot = lds + (c % R2_NS) * R2_SLOT;
            bf16x8 sb[2]; sb[0] = pack8(S[0], S[1]); sb[1] = pack8(S[2], S[3]);
            { unsigned char* sp = sg + (size_t)c * 64 * (NPC * 2); *(bf16x8*)sp = sb[0]; *(bf16x8*)(sp + 64) = sb[1]; }
            f32x4 aS[4];
#pragma unroll
            for (int mt = 0; mt < 4; ++mt) { const int po = l15 * 128 + (((2 * mt + (q >> 1)) ^ swi) * 16) + 8 * (q & 1);
                aS[mt] = *(LAS const f32x4*)(slot + 10240 + (16 * mt + 4 * q) * 4) * S[mt] + unpack4(*(LAS const u32x2*)(slot + 8192 + po)); }
#pragma unroll
            for (int ks = 0; ks < 2; ++ks)
#pragma unroll
                for (int mt = 0; mt < 4; ++mt) { const int jr = 16 * mt + l15; const bf16x8 pa = *(LAS const bf16x8*)(slot + jr * 128 + (((4 * ks + q) ^ ((jr >> 1) & 7)) * 16)); aS[mt] = mfma16(pa, sb[ks], aS[mt]); }
#pragma unroll
            for (int mt = 0; mt < 4; ++mt) S[mt] = aS[mt];
            asm volatile("s_waitcnt lgkmcnt(0)" ::: "memory"); __builtin_amdgcn_s_barrier(); asm volatile("" ::: "memory");
        }
    } else {
        for (int c = 0; c <= NCHUNK; ++c) __builtin_amdgcn_s_barrier();
    }
    WG_BAR();
}

__device__ __forceinline__ void r3_task(const Args& a, int l, int task, int lane) {
    unsigned char* ws = a.ws; const bf16_t* P = (const bf16_t*)(ws + WS_P); bf16_t* Y = (bf16_t*)(ws + WS_H);
    const int u = task >> 2, mt = task & 3, b = u >> 10, h = (u >> 7) & 7, c = u & 127, row0 = b * SEQ + c * 64, l15 = lane & 15, q = lane >> 4;
    const unsigned char* Du = ws + WS_D + (size_t)u * 32768;
    bf16x8 ra[2];
    { const int tl = 16 * mt + l15;
#pragma unroll
      for (int ks = 0; ks < 2; ++ks) ra[ks] = *(const bf16x8*)(Du + 8192 + tl * 128 + (((4 * ks + q) ^ ((tl >> 1) & 7)) * 16)); }
    f32x4 acc[4];
#pragma unroll
    for (int nt = 0; nt < 4; ++nt) { const int i = 16 * nt + l15; const unsigned char* sp = (const unsigned char*)P + (size_t)(row0 + i) * (NPC * 2) + h * 128 + 16 * q;
        const bf16x8 s0 = *(const bf16x8*)sp, s1 = *(const bf16x8*)(sp + 64);
        acc[nt] = unpack4(*(const u32x2*)(Du + 24576 + i * 128 + (((2 * mt + (q >> 1)) ^ ((i >> 1) & 7)) * 16) + 8 * (q & 1)));
        acc[nt] = mfma16(ra[0], s0, acc[nt]); acc[nt] = mfma16(ra[1], s1, acc[nt]); }
    const float* lnw = a.in[15] + l * RWW + h * 64; const float* lnb = a.in[16] + l * RWW + h * 64; const float* mu = a.in[7] + l * SHIFT_COLS + PC_V + h * 64;
#pragma unroll
    for (int r = 0; r < 4; ++r) { const int row = row0 + 16 * mt + 4 * q + r;
        float s = (acc[0][r] + acc[1][r]) + (acc[2][r] + acc[3][r]);
        s += __shfl_xor(s, 1); s += __shfl_xor(s, 2); s += __shfl_xor(s, 4); s += __shfl_xor(s, 8);
        const float mean = s * (1.f / 64.f); float d[4], v = 0.f;
#pragma unroll
        for (int nt = 0; nt < 4; ++nt) { d[nt] = acc[nt][r] - mean; v += d[nt] * d[nt]; }
        v += __shfl_xor(v, 1); v += __shfl_xor(v, 2); v += __shfl_xor(v, 4); v += __shfl_xor(v, 8);
        const float rstd = __builtin_amdgcn_rsqf(v * (1.f / 64.f) + 64e-5f);
        const bf16_t* pr = P + (size_t)row * NPC; const float bon = *(const float*)((const unsigned char*)pr + PC_PAD * 2 + h * 4); const bool hasprev = (row & (SEQ - 1)) != 0;
#pragma unroll
        for (int nt = 0; nt < 4; ++nt) { const int i = 16 * nt + l15; const float vc = bf2f(pr[PC_V + h * 64 + i]), vp = hasprev ? bf2f(pr[PC_V + h * 64 + i - NPC]) : 0.f, g = bf2f(pr[PC_G + h * 64 + i]);
            const float vs = vc + (vp - vc) * mu[i]; const float yn = d[nt] * rstd * lnw[i] + lnb[i] + bon * vs;
            Y[(size_t)row * DM + h * 64 + i] = (bf16_t)f2bf(yn * g * __builtin_amdgcn_rcpf(1.f + __expf(-g))); } }
}

__device__ __forceinline__ void phase_final(const Args& a, int lane, int wave, int G) {
    const int gw = blockIdx.x * 8 + wave, NGW = G * 8; const float* fg = a.in[18];
    for (int m = gw; m < MROWS; m += NGW) {
        f32x4* xr = (f32x4*)(a.out + (size_t)m * DM) + lane; f32x4 v[4]; float s = 0.f;
#pragma unroll
        for (int j = 0; j < 4; ++j) { v[j] = xr[64 * j]; s += (v[j][0] * v[j][0] + v[j][1] * v[j][1]) + (v[j][2] * v[j][2] + v[j][3] * v[j][3]); }
        const float rstd = 1.0f / sqrtf(wave_sum(s) * (1.f / DM) + 1e-6f);
#pragma unroll
        for (int j = 0; j < 4; ++j) { const f32x4 g = *(const f32x4*)(fg + 4 * lane + 256 * j); xr[64 * j] = v[j] * rstd * g; }
    }
}

#define XB_TMO      128
#define XB_XCNT(j)  (256  + 64 * (j))
#define XB_XSUB(j)  (1280 + 64 * (j))
#define XB_XGEN(j)  (2304 + 64 * (j))
#define XB_TOP      3328
#define XB_TOPGEN   3392
#define XCD_BAR_WORDS 3456
#define XB_SPIN_CAP (1u << 18)

__device__ __forceinline__ unsigned xb_ld(unsigned* p)              { return __hip_atomic_load(p, __ATOMIC_RELAXED, __HIP_MEMORY_SCOPE_AGENT); }
__device__ __forceinline__ unsigned xb_add(unsigned* p, unsigned v) { return __hip_atomic_fetch_add(p, v, __ATOMIC_RELAXED, __HIP_MEMORY_SCOPE_AGENT); }
__device__ __forceinline__ unsigned xb_xcc_id() { return (unsigned)__builtin_amdgcn_s_getreg((3 << 11) | 20) & 0xFu; }
#define XB_SPIN(cond, bar) do { unsigned _sp = 0; while (cond) { __builtin_amdgcn_s_sleep(1); \
    if ((++_sp & 255u) == 0u) { if (xb_ld(&(bar)[XB_TMO])) break; if (_sp > XB_SPIN_CAP) { atomicAdd(&(bar)[XB_TMO], 1u); break; } } } } while (0)

struct XcdBarrier {
    unsigned* bar; unsigned x;
    volatile LAS unsigned* st;
};

__device__ __forceinline__ XcdBarrier xcd_barrier_post(unsigned* bar, volatile LAS unsigned* st) {
    XcdBarrier b; b.bar = bar; b.x = xb_xcc_id(); b.st = st;
    if (threadIdx.x == 0) (void)xb_add(&bar[XB_XCNT(b.x)], 1u);
    return b;
}
__device__ __forceinline__ void xcd_barrier_complete(unsigned* bar, unsigned x, unsigned& nloc, unsigned& nx) {
    const unsigned G = gridDim.x * gridDim.y * gridDim.z;
    unsigned sum, cnt, mine, sp = 0u;
    for (;;) {
        sum = 0u; cnt = 0u; mine = 0u;
#pragma unroll
        for (unsigned j = 0; j < 16; ++j) { const unsigned c = xb_ld(&bar[XB_XCNT(j)]); sum += c; cnt += (c > 0u) ? 1u : 0u; mine = (j == x) ? c : mine; }
        if (sum == G) break;
        __builtin_amdgcn_s_sleep(1);
        if ((++sp & 255u) == 0u) { if (xb_ld(&bar[XB_TMO])) break; if (sp > XB_SPIN_CAP) { atomicAdd(&bar[XB_TMO], 1u); break; } }
    }
    nloc = mine > 0u ? mine : 1u; nx = cnt > 0u ? cnt : 1u;
}

__device__ __forceinline__ void xcd_barrier(const XcdBarrier& b) {
    asm volatile("s_waitcnt vmcnt(0)" ::: "memory");
    __syncthreads();
    if (threadIdx.x == 0) {
        unsigned* bar = b.bar;
        __builtin_amdgcn_s_waitcnt(0);
        unsigned nloc = b.st[0], nx = b.st[1];
        if (nloc == 0u) { xcd_barrier_complete(bar, b.x, nloc, nx); b.st[0] = nloc; b.st[1] = nx; }
        const unsigned old = xb_add(&bar[XB_XSUB(b.x)], 1u);
        const unsigned gen = old / nloc;
        if (old + 1u == (gen + 1u) * nloc) {
            __builtin_amdgcn_fence(__ATOMIC_RELEASE, "agent");
            asm volatile("s_waitcnt vmcnt(0)" ::: "memory");
            const unsigned og = xb_add(&bar[XB_TOP], 1u);
            const unsigned tg = og / nx;
            if (og + 1u == (tg + 1u) * nx) xb_add(&bar[XB_TOPGEN], 1u);
            else XB_SPIN(xb_ld(&bar[XB_TOPGEN]) == tg, bar);
            __builtin_amdgcn_fence(__ATOMIC_ACQUIRE, "agent");
            xb_add(&bar[XB_XGEN(b.x)], 1u);
            asm volatile("s_waitcnt vmcnt(0)" ::: "memory");
        } else {
            XB_SPIN(xb_ld(&bar[XB_XGEN(b.x)]) == gen, bar);
            __builtin_amdgcn_fence(__ATOMIC_ACQUIRE, "agent");
            asm volatile("s_waitcnt vmcnt(0)" ::: "memory");
        }
    }
    __syncthreads();
}

#ifndef MK_PER_PHASE
#define MK_PER_PHASE 0
#endif
#ifndef PHMASK
#define PHMASK 0x1ff
#endif
#ifndef DUPMASK
#define DUPMASK 0
#endif
#if MK_PER_PHASE
#define RUN(k) (a.ph_lo <= (k) && (k) < a.ph_hi)
#define SEAM(k) do { } while (0)
#else
#define RUN(k) true
#define SEAM(k) do { if ((k) == 1) grid.sync(); else xcd_barrier(bar); } while (0)
#endif
__global__ void __launch_bounds__(512, 2) fwd_kernel(Args a) {
    extern __shared__ __attribute__((aligned(16))) unsigned char lds_raw[];
    ldsp lds = (ldsp)lds_raw;
    cg::grid_group grid = cg::this_grid();
    int tid = threadIdx.x, lane = tid & 63, wave = __builtin_amdgcn_readfirstlane(tid >> 6); const int G = gridDim.x;
#define FRESH() do { tid = threadIdx.x; asm volatile("" : "+v"(tid)); lane = tid & 63; wave = __builtin_amdgcn_readfirstlane(tid >> 6); } while (0)
    unsigned char* ws = a.ws;
    if (threadIdx.x < 2) ((volatile LAS unsigned*)(lds + LDS_BYTES - 16))[threadIdx.x] = 0u;
    __syncthreads();
    const XcdBarrier bar = xcd_barrier_post((unsigned*)(ws + 806912), (volatile LAS unsigned*)(lds + LDS_BYTES - 16));
#ifdef TPROBE
    unsigned long long* tsb = (unsigned long long*)(ws + 802816);
#define STAMP(k) do { if (blockIdx.x == 0 && threadIdx.x == 0) tsb[k] = __builtin_amdgcn_s_memrealtime(); } while (0)
#else
#define STAMP(k) do { } while (0)
#endif
    STAMP(0);
    if (RUN(0)) { for (int rep = 0; rep < ((DUPMASK & 1) ? 2 : 1); ++rep) phase_p0(a, lds, tid, lane, wave, G); }
    { constexpr int l = 0;
        const int pb = 1 + 6 * l;
        const float* xin = l == 0 ? a.in[0] : a.out;
        SEAM(pb); FRESH(); STAMP(1 + 8 * l);
        if (RUN(pb)) { for (int rep = 0; rep < ((DUPMASK & 4) ? 2 : 1); ++rep) phase_h(a, lds, l, xin, tid, lane, wave, G); }
        SEAM(pb + 1); FRESH(); STAMP(2 + 8 * l);
        if (RUN(pb + 1)) { for (int rep = 0; rep < ((DUPMASK & 8) ? 2 : 1); ++rep) { pg8::Gemm g{(const bf16_t*)(ws + WS_H), (const bf16_t*)(ws + WS_WIN) + (size_t)l * NPC * DM, MROWS, NPC, DM}; pg8::StaticOrder S; S.init(MROWS, NPC, G, (int)blockIdx.x);
            pg8::EpiBf16 E{(bf16_t*)(ws + WS_P), NPC}; pg8::gemm_phase<pg8::EpiBf16, pg8::StaticOrder, true, true>(lds, g, S, E); } }
        SEAM(pb + 2); FRESH(); STAMP(3 + 8 * l);
        if (RUN(pb + 2)) {
            for (int rep = 0; rep < ((DUPMASK & 16) ? 2 : 1); ++rep) for (int u = blockIdx.x; u < 2048; u += G) r1_unit(a, lds, l, u, tid, lane, wave);
        }
        SEAM(pb + 3); FRESH(); STAMP(5 + 8 * l);
        if (RUN(pb + 3)) { for (int rep = 0; rep < ((DUPMASK & 64) ? 2 : 1); ++rep) { if (blockIdx.x < 64) { phase_r2(a, lds, tid, lane, wave); for (int task = 7168 + blockIdx.x * 16 + wave; task < 7168 + blockIdx.x * 16 + 16; task += 8) sb_task(a, lds + wave * 4608, l, task, lane); }
            else { const int gw = (blockIdx.x - 64) * 8 + wave, NGW = (G - 64) * 8; for (int task = gw; task < 7168; task += NGW) sb_task(a, lds + wave * 4608, l, task, lane); } } }
        SEAM(pb + 4); FRESH(); STAMP(6 + 8 * l);
        if (RUN(pb + 4)) { for (int rep = 0; rep < ((DUPMASK & 128) ? 2 : 1); ++rep) { const int gw = blockIdx.x * 8 + wave, NGW = G * 8; for (int task = gw; task < 8192; task += NGW) r3_task(a, l, task, lane); } }
        SEAM(pb + 5); FRESH(); STAMP(7 + 8 * l);
        if (RUN(pb + 5)) { for (int rep = 0; rep < ((DUPMASK & 256) ? 2 : 1); ++rep) { pg8::Gemm g{(const bf16_t*)(ws + WS_H), (const bf16_t*)(ws + WS_WOUT) + (size_t)l * DM * DM, MROWS, DM, DM}; pg8::StaticOrder S; S.init(MROWS, DM, G, (int)blockIdx.x);
            pg8::EpiRes E{xin, a.out, (const float*)(ws + WS_GATE) + l * 2048}; pg8::gemm_phase<pg8::EpiRes, pg8::StaticOrder, true, true>(lds, g, S, E); } }
        }
    { constexpr int l = 1;
        const int pb = 1 + 6 * l;
        const float* xin = l == 0 ? a.in[0] : a.out;
        SEAM(pb); FRESH(); STAMP(1 + 8 * l);
        if (RUN(pb)) { if (PHMASK & 4) phase_h(a, lds, l, xin, tid, lane, wave, G); }
        SEAM(pb + 1); FRESH(); STAMP(2 + 8 * l);
        if (RUN(pb + 1)) { if (PHMASK & 8) { pg8::Gemm g{(const bf16_t*)(ws + WS_H), (const bf16_t*)(ws + WS_WIN) + (size_t)l * NPC * DM, MROWS, NPC, DM}; pg8::StaticOrder S; S.init(MROWS, NPC, G, (int)blockIdx.x);
            pg8::EpiBf16 E{(bf16_t*)(ws + WS_P), NPC}; pg8::gemm_phase<pg8::EpiBf16, pg8::StaticOrder, true, true>(lds, g, S, E); } }
        SEAM(pb + 2); FRESH(); STAMP(3 + 8 * l);
        if (RUN(pb + 2)) {
            if (PHMASK & 16) for (int u = blockIdx.x; u < 2048; u += G) r1_unit(a, lds, l, u, tid, lane, wave);
        }
        SEAM(pb + 3); FRESH(); STAMP(5 + 8 * l);
        if (RUN(pb + 3)) { if (PHMASK & 64) { if (blockIdx.x < 64) { phase_r2(a, lds, tid, lane, wave); for (int task = 7168 + blockIdx.x * 16 + wave; task < 7168 + blockIdx.x * 16 + 16; task += 8) sb_task(a, lds + wave * 4608, l, task, lane); }
            else { const int gw = (blockIdx.x - 64) * 8 + wave, NGW = (G - 64) * 8; for (int task = gw; task < 7168; task += NGW) sb_task(a, lds + wave * 4608, l, task, lane); } } }
        SEAM(pb + 4); FRESH(); STAMP(6 + 8 * l);
        if (RUN(pb + 4)) { if (PHMASK & 128) { const int gw = blockIdx.x * 8 + wave, NGW = G * 8; for (int task = gw; task < 8192; task += NGW) r3_task(a, l, task, lane); } }
        SEAM(pb + 5); FRESH(); STAMP(7 + 8 * l);
        if (RUN(pb + 5)) { if (PHMASK & 256) { pg8::Gemm g{(const bf16_t*)(ws + WS_H), (const bf16_t*)(ws + WS_WOUT) + (size_t)l * DM * DM, MROWS, DM, DM}; pg8::StaticOrder S; S.init(MROWS, DM, G, (int)blockIdx.x);
            pg8::EpiRes E{xin, a.out, (const float*)(ws + WS_GATE) + l * 2048}; pg8::gemm_phase<pg8::EpiRes, pg8::StaticOrder, true, true>(lds, g, S, E); } }
        }
    SEAM(13); FRESH(); STAMP(17);
    if (RUN(13)) { if (PHMASK & 2) phase_final(a, lane, wave, G); }
#ifdef TPROBE
    STAMP(18); grid.sync();
    { float A_ = (float)(tsb[TP_A1] - tsb[TP_A0]) * 0.01f, B_ = (float)(tsb[TP_B1] - tsb[TP_B0]) * 0.01f;
      A_ = __expf(0.13976f * floorf(__logf(fmaxf(A_, 1.f)) / 0.13976f + 0.5f)); B_ = __expf(0.13976f * floorf(__logf(fmaxf(B_, 1.f)) / 0.13976f + 0.5f));
      for (int i = blockIdx.x * 512 + threadIdx.x; i < (1 << 20); i += G * 512) a.out[i] = i == 0 ? A_ * 1000.f : B_; }
#endif
}

#ifdef DBG_CHECK
#define ACC(k, got, want) do { const float g_ = (got), w_ = (want); const float d_ = g_ - w_; nm[k] += (d_ == d_) ? fminf(d_ * d_, 1e30f) : 1e30f; dn[k] += w_ * w_; } while (0)
__device__ __forceinline__ unsigned hsh(unsigned x) { x ^= x >> 16; x *= 0x7feb352du; x ^= x >> 15; x *= 0x846ca68bu; x ^= x >> 16; return x; }
__device__ __forceinline__ float dbg_silu(float x) { return x / (1.f + __expf(-x)); }
__device__ __forceinline__ float dbg_mod(const Args& a, int l, int b, int n) { float s = a.in[4][l * 3072 + n]; for (int k = 0; k < 1024; ++k) s += dbg_silu(a.in[1][b * 1024 + k]) * a.in[3][((size_t)l * 1024 + k) * 3072 + n]; return s; }
#define sh(col) (bf2f(pr[col]) + ((t > 0 ? bf2f(pr[(col) - NPC]) : 0.f) - bf2f(pr[col])) * mu[col])
#define DQ(Dp, mat, row, el) bf2f(*(const bf16_t*)((Dp) + (mat) * 8192 + (row) * 128 + ((((el) >> 3) ^ (((row) >> 1) & 7)) * 16) + ((el) & 7) * 2))
#define KP(jj) (32 * ((jj) >> 5) + 8 * (((jj) >> 2) & 3) + 4 * (((jj) >> 4) & 1) + ((jj) & 3))
constexpr int T0 = 7992;
__global__ void __launch_bounds__(256) dbg_check(Args a, int stage) {
    __shared__ float red[256]; __shared__ float st[64 * 65]; __shared__ float vec[8][64]; __shared__ float s64[64 * 65];
    float nm[16], dn[16];
#pragma unroll
    for (int i = 0; i < 16; ++i) { nm[i] = 0.f; dn[i] = 0.f; }
    unsigned char* ws = a.ws; float* err = (float*)(ws + WS_DBG); const int tid = threadIdx.x; float e = 0.f;
    const bf16_t* P = (const bf16_t*)(ws + WS_P); const bf16_t* Hb = (const bf16_t*)(ws + WS_H);
    if (stage == 1) {
        if (tid < 32) err[tid] = 0.f; __syncthreads();
        for (int s = tid; s < 4096; s += 256) { const unsigned r = hsh(s * 2654435761u + 17u); const int l = r & 1, n = (r >> 1) % NPC, k = (r >> 14) & 1023;
            const int sn = n < PC_PAD ? n : (n < PC_SQ ? -1 : n - 128); const float want = sn < 0 ? 0.f : bf2f(f2bf(a.in[5][((size_t)l * 1024 + k) * IN_COLS + sn]));
            ACC(1, bf2f(((const bf16_t*)(ws + WS_WIN))[((size_t)l * NPC + n) * 1024 + k]), want);
            const int n2 = n & 1023; ACC(1, bf2f(((const bf16_t*)(ws + WS_WOUT))[((size_t)l * 1024 + n2) * 1024 + k]), bf2f(f2bf(a.in[6][((size_t)l * 1024 + k) * 1024 + n2]))); }
    } else if (stage == 2) {
        for (int s = tid; s < 256; s += 256) { const unsigned r = hsh(s + 99u); const int m = r % MROWS, k = (r >> 15) & 1023, b = m >> 13;
            float ss = 0.f; for (int j = 0; j < 1024; ++j) { const float x = a.in[0][(size_t)m * 1024 + j]; ss += x * x; }
            const float rstd = 1.f / sqrtf(ss / 1024.f + 1e-6f); const float want = a.in[0][(size_t)m * 1024 + k] * rstd * a.in[2][k] * (1.f + dbg_mod(a, 0, b, 1024 + k)) + dbg_mod(a, 0, b, k);
            ACC(2, bf2f(Hb[(size_t)m * 1024 + k]), want);
            ACC(2, ((const float*)(ws + WS_GATE))[b * 1024 + k], dbg_mod(a, 0, b, 2048 + k)); }
    } else if (stage == 3) {
        for (int s = tid; s < 2048; s += 256) { const unsigned r = hsh(s + 777u); const int m = r % MROWS, n = (r >> 15) % NPC; float acc = 0.f;
            for (int k = 0; k < 1024; ++k) acc += bf2f(Hb[(size_t)m * 1024 + k]) * bf2f(((const bf16_t*)(ws + WS_WIN))[(size_t)n * 1024 + k]);
            ACC(3, bf2f(P[(size_t)m * NPC + n]), acc); }
    } else if (stage == 4) {
        const unsigned r = hsh(tid + 4242u); const int b = r & 1, h = (r >> 1) & 7; int t = (r >> 4) & 8191; if (tid < 40) t = tid;
        const bf16_t* qp = P + (size_t)(b * SEQ + t) * NPC + PC_SQ + h * 64; float* o = st + (tid & 63) * 65; for (int d = 0; d < 64; ++d) o[d] = 0.f; float after = 0.f; if (tid < 64) {
        for (int s = t - 1; s >= 0 && after > -110.f; --s) { const bf16_t* kp = P + (size_t)(b * SEQ + s) * NPC + PC_SK + h * 64; float z = 0.f; for (int d = 0; d < 64; ++d) z += bf2f(qp[d]) * bf2f(kp[d]); z *= 0.125f;
            const float sp = fmaxf(z, 0.f) + __logf(1.f + __expf(-fabsf(z))); const float w = __expf(z - sp + after); const bf16_t* vp = P + (size_t)(b * SEQ + s) * NPC + PC_SV + h * 64;
            for (int d = 0; d < 64; ++d) o[d] += w * bf2f(vp[d]); after -= sp; }
        float ss = 0.f; for (int d = 0; d < 64; ++d) ss += o[d] * o[d]; const float rms = 1.f / sqrtf(ss / 64.f + 1e-6f);
        for (int d = 0; d < 64; ++d) { const float g = bf2f(P[(size_t)(b * SEQ + t) * NPC + PC_SG + h * 64 + d]); const float want = o[d] * rms * a.in[17][h * 64 + d] * dbg_silu(g);
            ACC(4, bf2f(Hb[(size_t)(b * SEQ + t) * 1024 + 512 + h * 64 + d]), want); } }
    } else if (stage == 5 || stage == 6) {
        if (tid < 64) { const int b = stage == 5 ? 0 : 1, h = stage == 5 ? 0 : 5, j = tid, jg = h * 64 + j; const float* mu = a.in[7];
            for (int x = 0; x < 64; ++x) st[tid * 65 + x] = 0.f;
            float pd = 1.f;
            float* expy = (float*)(ws + WS_DBG + 4096) + (stage - 5) * 200 * 64;
            for (int t = 0; t < T0 + 200; ++t) { const bf16_t* pr = P + (size_t)(b * SEQ + t) * NPC;
                const float rr = sh(PC_R + jg), kr = sh(PC_K + jg), vv = sh(PC_V + jg); float wa = a.in[8][jg], aa = a.in[10][jg];
                for (int m = 0; m < 64; ++m) { wa += tanh_f(sh(PC_ZW + m)) * a.in[9][(size_t)m * 512 + jg]; aa += sh(PC_ZA + m) * a.in[11][(size_t)m * 512 + jg]; }
                const float sp = fmaxf(-wa, 0.f) + __logf(1.f + __expf(-fabsf(wa))); const float dec = __expf(-__expf(-sp - 0.5f)); const float av = 1.f / (1.f + __expf(-aa));
                float kk = kr * a.in[12][jg]; vec[6][j] = kk * kk; __syncthreads(); float n2 = 0.f; for (int x = 0; x < 64; ++x) n2 += vec[6][x]; kk *= 1.f / sqrtf(fmaxf(n2, 1e-24f));
                const float kp = kr * (1.f + (av - 1.f) * a.in[13][jg]);
                vec[0][j] = rr; vec[1][j] = dec; vec[2][j] = kp; vec[3][j] = vv; vec[4][j] = kk; vec[5][j] = kk * av; vec[7][j] = rr * kp * a.in[14][jg]; __syncthreads();
                float sa = 0.f; for (int x = 0; x < 64; ++x) sa += st[tid * 65 + x] * -vec[4][x];
                float y = 0.f; for (int x = 0; x < 64; ++x) { float s2 = st[tid * 65 + x] * vec[1][x] + sa * vec[5][x] + vec[3][tid] * vec[2][x]; st[tid * 65 + x] = s2; y += s2 * vec[0][x]; }
                float bon = 0.f; for (int x = 0; x < 64; ++x) bon += vec[7][x];
                __syncthreads(); vec[6][j] = y; __syncthreads(); float mean = 0.f; for (int x = 0; x < 64; ++x) mean += vec[6][x]; mean /= 64.f; float var = 0.f; for (int x = 0; x < 64; ++x) var += (vec[6][x] - mean) * (vec[6][x] - mean); var /= 64.f;
                const float yn = (y - mean) / sqrtf(var + 64e-5f) * a.in[15][jg] + a.in[16][jg] + bon * vv; const float g = bf2f(pr[PC_G + jg]);
                if (t >= T0) expy[(t - T0) * 64 + j] = y; if (t >= T0) expy[2 * 200 * 64 + (t - T0) * 64 + j] = yn * dbg_silu(g);
                { const int u0 = (b * 8 + h) * 128; const unsigned char* D0 = ws + WS_D + (size_t)u0 * 32768; const unsigned char* D1 = D0 + 32768; const int i = tid;
                  pd *= dec;
                  if (t < 64) ACC(11, DQ(D0, 3, i, t), y);
                  if (t == 63) { for (int x = 0; x < 64; ++x) { ACC(10, DQ(D0, 2, i, x), st[i * 65 + x]); s64[i * 65 + x] = st[i * 65 + x]; }
                      ACC(12, ((const float*)(ws + WS_GAM))[(size_t)u0 * 64 + j], pd); }
                  if (t >= 64 && t < 128) { float yp = DQ(D1, 3, i, t - 64); for (int x = 0; x < 64; ++x) yp += DQ(D1, 1, t - 64, KP(x)) * s64[i * 65 + x]; ACC(15, yp, y); }
                  if (t == 127) { for (int jp = 0; jp < 64; ++jp) { float sp2 = ((const float*)(ws + WS_GAM))[(size_t)(u0 + 1) * 64 + jp] * s64[i * 65 + jp] + DQ(D1, 2, i, jp);
                          for (int x = 0; x < 64; ++x) sp2 += DQ(D1, 0, jp, KP(x)) * s64[i * 65 + x]; ACC(14, sp2, st[i * 65 + jp]); } }
                }
                __syncthreads(); }
            }
    } else if (stage == 7 || stage == 8) {
        const float* expy = (const float*)(ws + WS_DBG + 4096);
        for (int which = 0; which < 2; ++which) { const int b = which ? 1 : 0, h = which ? 5 : 0;
            for (int s = tid; s < 200 * 64; s += 256) { const int t = s >> 6, j = s & 63;
                if (stage == 7) { const float gv = *(const float*)((const unsigned char*)P + (size_t)(b * SEQ + T0 + t) * NPC * 2 + (h * 64 + j) * 4); if (t < 64) ACC(7, gv, expy[which * 200 * 64 + s]); else ACC(13, gv, expy[which * 200 * 64 + s]); }
                else ACC(8, bf2f(Hb[(size_t)(b * SEQ + T0 + t) * 1024 + h * 64 + j]), expy[2 * 200 * 64 + which * 200 * 64 + s]); } }
    } else if (stage == 9) {
        for (int s = tid; s < 1024; s += 256) { const unsigned r = hsh(s + 31337u); const int m = r % MROWS, n = (r >> 15) & 1023, b = m >> 13; float acc = 0.f;
            for (int k = 0; k < 1024; ++k) acc += bf2f(Hb[(size_t)m * 1024 + k]) * bf2f(((const bf16_t*)(ws + WS_WOUT))[(size_t)n * 1024 + k]);
            ACC(9, a.out[(size_t)m * 1024 + n], a.in[0][(size_t)m * 1024 + n] + ((const float*)(ws + WS_GATE))[b * 1024 + n] * acc); }
    } else if (stage == 20) {
        const unsigned char* dump = ws + WS_DUMP; float* REF = (float*)(ws + WS_DUMP + 156672);
        float* Rr = REF, *Rc = REF + 4096, *Rkp = REF + 8192, *Rv = REF + 12288, *Rkk = REF + 16384, *Ra = REF + 20480;
        { const int t = tid >> 2, jq = tid & 3; const bf16_t* pr = P + (size_t)t * NPC; const float* mu = a.in[7]; float n2 = 0.f;
          for (int jj = 0; jj < 16; ++jj) { const int j = jq * 16 + jj; const float kr = sh(PC_K + j); const float kk = kr * a.in[12][j]; n2 += kk * kk; }
          n2 += __shfl_xor(n2, 1); n2 += __shfl_xor(n2, 2); const float rn = 1.f / sqrtf(fmaxf(n2, 1e-24f));
          for (int jj = 0; jj < 16; ++jj) { const int j = jq * 16 + jj; const float rr = sh(PC_R + j), kr = sh(PC_K + j), vv = sh(PC_V + j); float wa = a.in[8][j], aa = a.in[10][j];
              for (int m = 0; m < 64; ++m) { wa += tanh_f(sh(PC_ZW + m)) * a.in[9][(size_t)m * 512 + j]; aa += sh(PC_ZA + m) * a.in[11][(size_t)m * 512 + j]; }
              const float sp = fmaxf(-wa, 0.f) + __logf(1.f + __expf(-fabsf(wa))); const float av = 1.f / (1.f + __expf(-aa));
              Rr[t * 64 + j] = rr; Rc[t * 64 + j] = -__expf(-sp - 0.5f); Rkp[t * 64 + j] = kr * (1.f + (av - 1.f) * a.in[13][j]); Rv[t * 64 + j] = vv; Rkk[t * 64 + j] = kr * a.in[12][j] * rn; Ra[t * 64 + j] = av; } }
        __threadfence(); __syncthreads();
        if (tid < 64) { float c = 0.f; for (int t = 0; t < 64; ++t) { c += Rc[t * 64 + tid]; Rc[t * 64 + tid] = c; } }
        __threadfence(); __syncthreads();
#define DM_(off, row, col) bf2f(*(const bf16_t*)(dump + (off) + (row) * 144 + (col) * 2))
        for (int s = tid; s < 4096; s += 256) { const int t = s >> 6, j = s & 63; const float ci = Rc[s], ce = t ? Rc[s - 64] : 0.f, ct = Rc[63 * 64 + j], kk = Rkk[s], av = Ra[s], kp = Rkp[s];
            const float Ag = -kk * __expf(ce), Rg = Rr[s] * __expf(ci), Bg = kk * av * __expf(-ci), Kg = kp * __expf(-ci);
            ACC(1, DM_(0, t, j), Ag); ACC(2, DM_(9216, t, j), Rg); ACC(3, DM_(18432, t, j), Bg); ACC(4, DM_(27648, t, j), Kg);
            ACC(5, DM_(36864, j, t), Ag); ACC(6, DM_(46080, j, t), kk * av * __expf(ct - ci)); ACC(6, DM_(55296, j, t), kp * __expf(ct - ci)); ACC(7, DM_(64512, j, t), Rv[s]); }
        for (int s = tid; s < 4096; s += 256) { const int t = s >> 6, u_ = s & 63; float ab = 0.f, ak = 0.f, rb = 0.f, rk = 0.f;
            for (int j = 0; j < 64; ++j) { const float ag = DM_(0, t, j), rg = DM_(9216, t, j), bg = DM_(18432, u_, j), kg = DM_(27648, u_, j); ab += ag * bg; ak += ag * kg; rb += rg * bg; rk += rg * kg; }
            if (!(u_ < t)) { ab = 0.f; ak = 0.f; } if (!(u_ <= t)) { rb = 0.f; rk = 0.f; }
            ACC(8, DM_(73728, t, u_), ab); ACC(8, DM_(73728 + 9216, u_, t), ab); ACC(9, DM_(92160, t, u_), ak); ACC(9, DM_(92160 + 9216, t, u_), rb); ACC(9, DM_(92160 + 18432, t, u_), rk); }
        if (tid < 64) { for (int t = 0; t < 64; ++t) { float v = (t == tid) ? 1.f : 0.f; for (int k = 0; k < t; ++k) v += DM_(73728, t, k) * st[k * 65 + tid]; st[t * 65 + tid] = v; } }
        __syncthreads();
        for (int s = tid; s < 4096; s += 256) { const int t = s >> 6, u_ = s & 63; ACC(10, DM_(119808, t, u_), st[t * 65 + u_]);
            float akv = 0.f; for (int k = 0; k < 64; ++k) akv += DM_(92160, u_, k) * DM_(64512, t, k);
            ACC(11, DM_(129024, t, u_), akv); ACC(14, DM_(-49152, t, u_), akv); }
        for (int s = tid; s < 8192; s += 256) { const int n = s >> 6, t = s & 63; float x = 0.f; for (int k = 0; k < 64; ++k) x += DM_(119808, t, k) * (n < 64 ? DM_(36864, n, k) : DM_(129024, n - 64, k));
            ACC(12, DM_(138240, n, t), x); }
        { const unsigned char* D0 = ws + WS_D;
          for (int s = tid; s < 4096; s += 256) { const int r_ = s >> 6, c_ = s & 63; float pp = 0.f, y0 = 0.f;
              for (int k = 0; k < 64; ++k) { pp += DM_(46080, r_, k) * DM_(138240, c_, k); y0 += DM_(92160 + 9216, c_, k) * DM_(138240, 64 + r_, k) + DM_(92160 + 18432, c_, k) * DM_(64512, r_, k); }
              ACC(13, DQ(D0, 0, r_, KP(c_)), pp); ACC(13, DQ(D0, 3, r_, c_), y0); } }
    } else if (stage == 30) {
        for (int s = tid; s < 256; s += 256) { const unsigned r = hsh(s + 555u); const int m = r % MROWS, k = (r >> 15) & 1023, b = m >> 13;
            float ss = 0.f; for (int j = 0; j < 1024; ++j) { const float x = a.out[(size_t)m * 1024 + j]; ss += x * x; }
            const float rstd = 1.f / sqrtf(ss / 1024.f + 1e-6f); const float want = a.out[(size_t)m * 1024 + k] * rstd * a.in[2][1024 + k] * (1.f + dbg_mod(a, 1, b, 1024 + k)) + dbg_mod(a, 1, b, k);
            ACC(5, bf2f(Hb[(size_t)m * 1024 + k]), want);
            ACC(5, ((const float*)(ws + WS_GATE))[2048 + b * 1024 + k], dbg_mod(a, 1, b, 2048 + k)); }
    } else if (stage == 31) {
        for (int s = tid; s < 256; s += 256) { const unsigned r = hsh(s + 888u); const int m = r % MROWS; float ss = 0.f;
            for (int j = 0; j < 1024; ++j) { const float x = a.out[(size_t)m * 1024 + j] / a.in[18][j]; ss += x * x; } ACC(6, ss / 1024.f, 1.f); }
    } else if (stage == 99) {
        for (int i = tid; i < MROWS * DM; i += 256) a.out[i] = 0.f;
        __syncthreads();
        if (tid == 0) { for (int k = 1; k <= 14; ++k) if (!(err[16 + k] < 0.03f)) { a.out[0] = (float)(10 + k) * 1e6f; return; } }
        if (tid == 0) { const float th[9] = {0.003f, 0.005f, 0.01f, 0.02f, 0.03f, 0.05f, 0.1f, 0.3f, 1.0f}; int c8 = 9, c13 = 9, c5 = 9, c6 = 9;
            for (int i = 8; i >= 0; --i) { if (err[8] < th[i]) c8 = i; if (err[13] < th[i]) c13 = i; if (err[5] < th[i]) c5 = i; if (err[6] < th[i]) c6 = i; }
            float pw = 1e6f; for (int z = 0; z < c5 + (c6 > 4 ? 10 : 0); ++z) pw *= 10.f; a.out[0] = (float)(10 * (1 + (c8 > 8 ? 8 : c8)) + c13) * pw; return; }
        if (tid == 0) { const int lo[6] = {7, 13, 10, 11, 12, 14}; const int hi[4] = {15, 8, 9, 0}; int lb = 0, hb = 0;
            for (int i = 0; i < 6; ++i) if (!(err[lo[i]] < 0.03f)) lb |= 1 << i;
            for (int i = 0; i < 3; ++i) if (!(err[hi[i]] < 0.03f)) hb |= 1 << i;
            if (!(err[1] < 0.03f) || !(err[2] < 0.03f) || !(err[3] < 0.03f) || !(err[4] < 0.03f)) hb |= 8;
            if (lb | hb) { float pw = 1e4f; for (int z = 0; z < hb; ++z) pw *= 10.f; a.out[0] = (float)(10 + lb) * pw; } }
        return;
    }
    __syncthreads();
#pragma unroll
    for (int k = 1; k < 16; ++k) { if (stage == 6 && k >= 10) continue; if ((stage == 5 || stage == 6) && k < 10) continue; red[tid] = nm[k]; __syncthreads(); float n_ = 0.f; if (tid == 0) for (int i = 0; i < 256; ++i) n_ += red[i]; __syncthreads(); red[tid] = dn[k]; __syncthreads();
        if (tid == 0) { float d_ = 0.f; for (int i = 0; i < 256; ++i) d_ += red[i]; if (n_ > 0.f || d_ > 0.f) err[(stage == 20 ? 16 : 0) + k] = sqrtf(n_ / (d_ + 1e-30f)); } __syncthreads(); }
}
#endif
extern "C" void kernel_launch(void* const* d_in, const int* in_sizes, int n_in, void* d_out, int out_size, void* d_ws, size_t ws_size, hipStream_t stream) {
    static int grid = 0;
    if (grid == 0) {
        if (n_in != 19 || out_size != MROWS * DM || ws_size < WS_END) { fprintf(stderr, "kernel_launch: unexpected shapes (n_in %d, out %d, ws %zu)\n", n_in, out_size, ws_size); grid = -1; return; }
        int dev = 0, cus = 0, per_cu = 0;
        (void)hipGetDevice(&dev); (void)hipDeviceGetAttribute(&cus, hipDeviceAttributeMultiprocessorCount, dev);
        if (hipFuncSetAttribute((const void*)fwd_kernel, hipFuncAttributeMaxDynamicSharedMemorySize, LDS_BYTES) != hipSuccess) { fprintf(stderr, "kernel_launch: hipFuncSetAttribute failed\n"); grid = -1; return; }
        if (hipOccupancyMaxActiveBlocksPerMultiprocessor(&per_cu, (const void*)fwd_kernel, 512, LDS_BYTES) != hipSuccess || per_cu < 1) { fprintf(stderr, "kernel_launch: occupancy query says %d\n", per_cu); per_cu = 1; }
        (void)hipGetLastError();
        grid = cus * 1;
        if (grid < 16) { grid = -1; return; }
    }
    if (grid < 0) return;
    Args a{};
    for (int i = 0; i < 19; ++i) a.in[i] = (const float*)d_in[i];
    a.out = (float*)d_out; a.ws = (unsigned char*)d_ws;
#if MK_PER_PHASE
    for (int ph = 0; ph < NPHASE; ++ph) { a.ph_lo = ph; a.ph_hi = ph + 1; hipLaunchKernelGGL(fwd_kernel, dim3(grid), dim3(512), LDS_BYTES, stream, a);
#ifdef DBG_CHECK
        if (ph == 0) hipLaunchKernelGGL(dbg_check, dim3(1), dim3(256), 0, stream, a, 1);
        if (ph == 1) hipLaunchKernelGGL(dbg_check, dim3(1), dim3(256), 0, stream, a, 2);
        if (ph == 2) hipLaunchKernelGGL(dbg_check, dim3(1), dim3(256), 0, stream, a, 3);
        if (ph == 3) { hipLaunchKernelGGL(dbg_check, dim3(1), dim3(256), 0, stream, a, 20); hipLaunchKernelGGL(dbg_check, dim3(1), dim3(256), 0, stream, a, 4); hipLaunchKernelGGL(dbg_check, dim3(1), dim3(256), 0, stream, a, 5); hipLaunchKernelGGL(dbg_check, dim3(1), dim3(256), 0, stream, a, 6); }
        if (ph == 4) hipLaunchKernelGGL(dbg_check, dim3(1), dim3(256), 0, stream, a, 7);
        if (ph == 5) hipLaunchKernelGGL(dbg_check, dim3(1), dim3(256), 0, stream, a, 8);
        if (ph == 6) hipLaunchKernelGGL(dbg_check, dim3(1), dim3(256), 0, stream, a, 9);
        if (ph == 7) hipLaunchKernelGGL(dbg_check, dim3(1), dim3(256), 0, stream, a, 30);
        if (ph == NPHASE - 1) { hipLaunchKernelGGL(dbg_check, dim3(1), dim3(256), 0, stream, a, 31); hipLaunchKernelGGL(dbg_check, dim3(1), dim3(256), 0, stream, a, 99); }
#endif
    }
#else
    a.ph_lo = 0; a.ph_hi = NPHASE;
    (void)hipMemsetAsync((unsigned char*)d_ws + 806912, 0, 16384, stream);
    void* args[] = {&a};
    hipError_t e = hipLaunchCooperativeKernel((const void*)fwd_kernel, dim3(grid), dim3(512), args, LDS_BYTES, stream);
    if (e != hipSuccess) fprintf(stderr, "cooperative launch failed: %s (grid %d)\n", hipGetErrorString(e), grid);
#endif
}
```

```cpp
#include <hip/hip_runtime.h>
#include <hip/hip_cooperative_groups.h>
#include <cstdio>
#include <cstdint>
namespace cg = cooperative_groups;
namespace pg8 {
#define PG8_LAS __attribute__((address_space(3)))
typedef unsigned short bf16_t;
typedef short bf16x8 __attribute__((ext_vector_type(8)));
typedef float f32x4 __attribute__((ext_vector_type(4)));
typedef unsigned u32x4 __attribute__((ext_vector_type(4)));
constexpr int BM = 256, BK = 64, HALF = 128, HTB = HALF * BK * 2  , STAGE_BYTES = 8 * HTB, NXCD = 8, WGM = 8;

__host__ __device__ __forceinline__ int lds_byte(int r, int c) { const int st = (r >> 4) * 2 + (c >> 5), rr = r & 15, cc = c & 31, ob = rr * 64 + cc * 2; return st * 1024 + (ob ^ (((ob >> 9) & 1) << 5)); }
__host__ __device__ __forceinline__ void stage_rc(int b, int& R, int& C) { const int st = b / 1024, sb = b % 1024, swz = sb ^ (((sb >> 9) & 1) << 5); R = (st >> 1) * 16 + swz / 64; C = (st & 1) * 32 + (swz % 64) / 2; }
__host__ __device__ __forceinline__ int perm32(int rho) { const int n = rho >> 4, i = rho & 15; return 8 * (i >> 2) + 4 * n + (i & 3); }

struct Unit { int pm, pn; };
struct Gemm { const bf16_t* A; const bf16_t* Bt; int M, N, K; };

struct StaticOrder {
    int nM, nN, nwg, G, c;
    __host__ __device__ void init(int M, int N, int G_, int c_) { nM = M / BM; nN = N / BM; nwg = nM * nN; G = G_; c = c_; }
    __host__ __device__ bool next(int i, Unit& u) const {
        const long L = (long)i * G + c; if (L >= nwg) return false;
        int wgid = (int)L; { const int q = nwg / NXCD, r = nwg % NXCD, xcd = wgid % NXCD, off = wgid / NXCD; wgid = (xcd < r ? xcd * (q + 1) : r * (q + 1) + (xcd - r) * q) + off; }
        const int nig = WGM * nN, gid = wgid / nig, fm = gid * WGM, gsz = (nM - fm) < WGM ? (nM - fm) : WGM;
        u.pm = fm + ((wgid % nig) % gsz); u.pn = (wgid % nig) / gsz; return true;
    }
    __device__ __forceinline__ void a_ready(const Unit&) const {}
    __device__ __forceinline__ void done(const Unit&) const {}
};

typedef __bf16 bf16v2_t __attribute__((ext_vector_type(2)));
typedef float f32v2_t __attribute__((ext_vector_type(2)));
__device__ __forceinline__ unsigned cvt_pk_bf16(float lo, float hi) { f32v2_t v = {lo, hi}; bf16v2_t b = __builtin_convertvector(v, bf16v2_t); return __builtin_bit_cast(unsigned, b); }
struct EpiBf16 {
    static constexpr bool PERM = true, AFTER_DRAIN = false;
    bf16_t* O; int ldc;
    __device__ __forceinline__ void operator()(const f32x4 (&acc)[2][2][4][2], const Unit& u, int wr, int wc, int fr, int fq) const {
        const int row0 = u.pm * BM + wr * 64 + fr; const int col0 = u.pn * BM + wc * 32 + 8 * fq;
#pragma unroll
        for (int ai = 0; ai < 2; ++ai)
#pragma unroll
            for (int m = 0; m < 4; ++m) { bf16_t* rowp = O + (size_t)(row0 + ai * HALF + m * 16) * ldc + col0;
#pragma unroll
                for (int bj = 0; bj < 2; ++bj) { const f32x4 v0 = acc[ai][bj][m][0], v1 = acc[ai][bj][m][1];
                    u32x4 w; w.x = cvt_pk_bf16(v0[0], v0[1]); w.y = cvt_pk_bf16(v0[2], v0[3]); w.z = cvt_pk_bf16(v1[0], v1[1]); w.w = cvt_pk_bf16(v1[2], v1[3]);
                    *(u32x4*)(rowp + bj * HALF) = w; } }
    }
    __device__ __forceinline__ void fused(f32x4 (&)[2][2][4][2], const Unit&, int, int, int, int, PG8_LAS unsigned char*, int, int) const {}
};
struct EpiRes {
    static constexpr bool PERM = false, AFTER_DRAIN = false;
    const float* xin; float* out; const float* gate;
    __device__ __forceinline__ void operator()(const f32x4 (&acc)[2][2][4][2], const Unit& u, int wr, int wc, int fr, int fq) const {
        const int row0 = u.pm * BM + wr * 64 + fr; const int col0 = u.pn * BM + wc * 32 + 4 * fq; const float* gp = gate + ((u.pm * BM) >> 13) * 1024;
        f32x4 gv[2][2];
#pragma unroll
        for (int bj = 0; bj < 2; ++bj)
#pragma unroll
            for (int n = 0; n < 2; ++n) gv[bj][n] = *(const f32x4*)(gp + col0 + bj * HALF + n * 16);
#pragma unroll
        for (int ai = 0; ai < 2; ++ai)
#pragma unroll
            for (int m = 0; m < 4; ++m) { const size_t off = (size_t)(row0 + ai * HALF + m * 16) * 1024 + col0;
#pragma unroll
                for (int bj = 0; bj < 2; ++bj)
#pragma unroll
                    for (int n = 0; n < 2; ++n) { const f32x4 xv = *(const f32x4*)(xin + off + bj * HALF + n * 16);
                        *(f32x4*)(out + off + bj * HALF + n * 16) = xv + gv[bj][n] * acc[ai][bj][m][n]; } }
    }
    __device__ __forceinline__ void fused(f32x4 (&)[2][2][4][2], const Unit&, int, int, int, int, PG8_LAS unsigned char*, int, int) const {}
};
template <class Epi, class Sched, bool ALIGN_EPI = false, bool SP2 = false>
__device__ __forceinline__ void gemm_phase(PG8_LAS unsigned char* lds, const Gemm g, const Sched& S, const Epi& E) {
    const int tid = threadIdx.x, wid = __builtin_amdgcn_readfirstlane(tid >> 6), lane = tid & 63, wr = wid >> 2, wc = wid & 3, fr = lane & 15, fq = lane >> 4;
    const int K = g.K, nt = K / BK;
    unsigned voffA[2], voffB[2];
#pragma unroll
    for (int i = 0; i < 2; ++i) { int R, C; stage_rc(tid * 16 + i * 8192, R, C); const int Rb = Epi::PERM ? ((R & ~31) + perm32(R & 31)) : R;
        voffA[i] = (unsigned)(R * K + C) * 2u; voffB[i] = (unsigned)(Rb * K + C) * 2u; }
    const size_t kstep = (size_t)(BK * 2);
    const size_t hstep = (size_t)HALF * K * 2;
    const size_t tstep = 2 * hstep;
    const unsigned ldsw = (unsigned)wid * 1024u;
    const int aoff = lds_byte(wr * 64 + fr, fq * 8), boff = lds_byte(wc * 32 + fr, fq * 8);
#define PG8_SA(b, h) (((b) * 2 + (h)) * HTB)
#define PG8_SB(b, h) ((4 + (b) * 2 + (h)) * HTB)
#define PG8_STAGE(bufoff, gbase, voff) do { _Pragma("unroll") for (int _i = 0; _i < 2; ++_i) \
        __builtin_amdgcn_global_load_lds((const unsigned*)((const char*)(gbase) + (voff)[_i]), (PG8_LAS unsigned*)(lds + (bufoff) + ldsw + _i * 8192), 16, 0, 0); } while (0)
#define PG8_LDA(dst, b, h) do { _Pragma("unroll") for (int m = 0; m < 4; ++m) _Pragma("unroll") for (int k = 0; k < 2; ++k) dst[m][k] = *(const PG8_LAS bf16x8*)(lds + PG8_SA(b, h) + aoff + m * 2048 + k * 1024); } while (0)
#define PG8_LDB(dst, b, h) do { _Pragma("unroll") for (int n = 0; n < 2; ++n) _Pragma("unroll") for (int k = 0; k < 2; ++k) dst[n][k] = *(const PG8_LAS bf16x8*)(lds + PG8_SB(b, h) + boff + n * 2048 + k * 1024); } while (0)
#define PG8_MMA(ai, bj, At, Bt) do { __builtin_amdgcn_s_setprio(1); _Pragma("unroll") for (int m = 0; m < 4; ++m) _Pragma("unroll") for (int n = 0; n < 2; ++n) _Pragma("unroll") for (int k = 0; k < 2; ++k) \
        acc[ai][bj][m][n] = __builtin_amdgcn_mfma_f32_16x16x32_bf16(Bt[n][k], At[m][k], acc[ai][bj][m][n], 0, 0, 0); __builtin_amdgcn_s_setprio(0); } while (0)
#define PG8_WAIT_V(n) asm volatile("s_waitcnt vmcnt(" #n ")" ::: "memory")
#define PG8_WAIT_L(n) asm volatile("s_waitcnt lgkmcnt(" #n ")" ::: "memory")
#define PG8_BAR __builtin_amdgcn_s_barrier()
#define PG8_SCHED __builtin_amdgcn_sched_barrier(0)
    Unit cur, nxt; int ui = 0;
    if (!S.next(0, cur)) return;
    f32x4 acc[2][2][4][2];
#pragma unroll
    for (int a = 0; a < 2; ++a)
#pragma unroll
        for (int b = 0; b < 2; ++b)
#pragma unroll
            for (int m = 0; m < 4; ++m)
#pragma unroll
                for (int n = 0; n < 2; ++n) acc[a][b][m][n] = (f32x4){0.f, 0.f, 0.f, 0.f};
    bf16x8 At[4][2], B0[2][2], B1[2][2];
    const char* cA = (const char*)g.A + (size_t)cur.pm * tstep; const char* cB = (const char*)g.Bt + (size_t)cur.pn * tstep;
    S.a_ready(cur);
    if constexpr (SP2) {
        PG8_STAGE(PG8_SB(0, 0), cB, voffB); PG8_STAGE(PG8_SB(0, 1), cB + hstep, voffB); PG8_STAGE(PG8_SA(0, 0), cA, voffA); PG8_STAGE(PG8_SA(0, 1), cA + hstep, voffA);
        if (wr == 1) PG8_BAR;
        PG8_WAIT_V(2); PG8_BAR;
        PG8_STAGE(PG8_SB(1, 0), cB + kstep, voffB); PG8_STAGE(PG8_SA(1, 0), cA + kstep, voffA); PG8_STAGE(PG8_SB(1, 1), cB + hstep + kstep, voffB);
        PG8_WAIT_V(6); PG8_BAR;
    } else {
        PG8_STAGE(PG8_SB(0, 0), cB, voffB); PG8_STAGE(PG8_SA(0, 0), cA, voffA); PG8_STAGE(PG8_SB(0, 1), cB + hstep, voffB); PG8_STAGE(PG8_SA(0, 1), cA + hstep, voffA);
        if (wr == 1) PG8_BAR;
        PG8_WAIT_V(4); PG8_BAR;
        PG8_STAGE(PG8_SB(1, 0), cB + kstep, voffB); PG8_STAGE(PG8_SA(1, 0), cA + kstep, voffA); PG8_STAGE(PG8_SB(1, 1), cB + hstep + kstep, voffB);
        PG8_WAIT_V(6); PG8_BAR;
    }
    for (;;) {
        const bool has_next = S.next(ui + 1, nxt);
        const char* nA = has_next ? (const char*)g.A + (size_t)nxt.pm * tstep : cA; const char* nB = has_next ? (const char*)g.Bt + (size_t)nxt.pn * tstep : cB;
        for (int t = 0; t < nt; t += 2) {
            const bool last = (t == nt - 2);
            const char* a1 = cA + (size_t)(t + 1) * kstep;
            const char* a2 = last ? nA : cA + (size_t)(t + 2) * kstep; const char* b2 = last ? nB : cB + (size_t)(t + 2) * kstep;
            const char* a3 = a2 + kstep; const char* b3 = b2 + kstep;
            if (last && has_next) S.a_ready(nxt);
            if constexpr (SP2) {
            PG8_LDB(B0, 0, 0); PG8_LDB(B1, 0, 1); PG8_SCHED; PG8_LDA(At, 0, 0); PG8_STAGE(PG8_SA(1, 1), a1 + hstep, voffA);
            PG8_WAIT_V(8); PG8_WAIT_L(0); PG8_BAR; PG8_MMA(0, 0, At, B0); PG8_MMA(0, 1, At, B1); PG8_BAR; PG8_SCHED;
            PG8_LDA(At, 0, 1); PG8_STAGE(PG8_SB(0, 0), b2, voffB); PG8_STAGE(PG8_SB(0, 1), b2 + hstep, voffB); PG8_STAGE(PG8_SA(0, 0), a2, voffA);
            PG8_WAIT_V(8); PG8_WAIT_L(0); PG8_BAR; PG8_MMA(1, 0, At, B0); PG8_MMA(1, 1, At, B1); PG8_BAR; PG8_SCHED;
            PG8_LDB(B0, 1, 0); PG8_LDB(B1, 1, 1); PG8_SCHED; PG8_LDA(At, 1, 0); PG8_STAGE(PG8_SA(0, 1), a2 + hstep, voffA);
            PG8_WAIT_V(8); PG8_WAIT_L(0); PG8_BAR; PG8_MMA(0, 0, At, B0); PG8_MMA(0, 1, At, B1); PG8_BAR; PG8_SCHED;
            PG8_LDA(At, 1, 1); PG8_STAGE(PG8_SB(1, 0), b3, voffB); PG8_STAGE(PG8_SB(1, 1), b3 + hstep, voffB); PG8_STAGE(PG8_SA(1, 0), a3, voffA);
            PG8_WAIT_V(8); PG8_WAIT_L(0); PG8_BAR; PG8_MMA(1, 0, At, B0); PG8_MMA(1, 1, At, B1); PG8_BAR; PG8_SCHED;
            } else {
            PG8_LDB(B0, 0, 0); PG8_SCHED; PG8_LDA(At, 0, 0); PG8_STAGE(PG8_SA(1, 1), a1 + hstep, voffA);
            PG8_WAIT_L(8); PG8_BAR; PG8_WAIT_L(0); PG8_MMA(0, 0, At, B0); PG8_BAR; PG8_SCHED;
            PG8_LDB(B1, 0, 1); PG8_STAGE(PG8_SB(0, 0), b2, voffB);
            PG8_BAR; PG8_WAIT_L(0); PG8_MMA(0, 1, At, B1); PG8_BAR;
            PG8_LDA(At, 0, 1); PG8_STAGE(PG8_SA(0, 0), a2, voffA);
            PG8_BAR; PG8_WAIT_L(0); PG8_MMA(1, 0, At, B0); PG8_BAR; PG8_SCHED;
            PG8_STAGE(PG8_SB(0, 1), b2 + hstep, voffB);
            PG8_WAIT_V(6); PG8_BAR; PG8_MMA(1, 1, At, B1); PG8_BAR;
            PG8_LDB(B0, 1, 0); PG8_SCHED; PG8_LDA(At, 1, 0); PG8_STAGE(PG8_SA(0, 1), a2 + hstep, voffA);
            PG8_WAIT_L(8); PG8_BAR; PG8_WAIT_L(0); PG8_MMA(0, 0, At, B0); PG8_BAR; PG8_SCHED;
            PG8_LDB(B1, 1, 1); PG8_STAGE(PG8_SB(1, 0), b3, voffB);
            PG8_BAR; PG8_WAIT_L(0); PG8_MMA(0, 1, At, B1); PG8_BAR;
            PG8_LDA(At, 1, 1); PG8_STAGE(PG8_SA(1, 0), a3, voffA);
            PG8_BAR; PG8_WAIT_L(0); PG8_MMA(1, 0, At, B0); PG8_BAR; PG8_SCHED;
            PG8_STAGE(PG8_SB(1, 1), b3 + hstep, voffB);
            PG8_WAIT_V(6); PG8_BAR; PG8_MMA(1, 1, At, B1); PG8_BAR;
            }
        }
        if constexpr (ALIGN_EPI) { if (wr == 0) PG8_BAR; }
        if constexpr (!Epi::AFTER_DRAIN) { E(acc, cur, wr, wc, fr, fq); S.done(cur); }
        if (!has_next) break;
#pragma unroll
        for (int a = 0; a < 2; ++a)
#pragma unroll
            for (int b = 0; b < 2; ++b)
#pragma unroll
                for (int m = 0; m < 4; ++m)
#pragma unroll
                    for (int n = 0; n < 2; ++n) acc[a][b][m][n] = (f32x4){0.f, 0.f, 0.f, 0.f};
        cur = nxt; cA = nA; cB = nB; ++ui;
        if constexpr (ALIGN_EPI) { if (wr == 1) PG8_BAR; }
    }
    PG8_WAIT_V(0);
    if constexpr (!ALIGN_EPI) { if (wr == 0) PG8_BAR; }
    PG8_BAR;
    if constexpr (Epi::AFTER_DRAIN) { E.fused(acc, cur, wr, wc, fr, fq, lds, wid, lane); S.done(cur); }
#undef PG8_SA
#undef PG8_SB
#undef PG8_STAGE
#undef PG8_LDA
#undef PG8_LDB
#undef PG8_MMA
#undef PG8_WAIT_V
#undef PG8_WAIT_L
#undef PG8_BAR
#undef PG8_SCHED
}
}
#define LAS __attribute__((address_space(3)))
typedef unsigned short bf16_t;
typedef short bf16x8 __attribute__((ext_vector_type(8)));
typedef float f32x4 __attribute__((ext_vector_type(4)));
typedef unsigned u32x4 __attribute__((ext_vector_type(4)));
typedef unsigned u32x2 __attribute__((ext_vector_type(2)));
typedef LAS unsigned char* ldsp;

constexpr int BATCH = 2, SEQ = 8192, DM = 1024, MROWS = BATCH * SEQ, NH = 8, HD = 64, RWW = 512;
constexpr int NPC = 4352;
constexpr int PC_R = 0, PC_K = 512, PC_V = 1024, PC_ZW = 1536, PC_ZA = 1600, PC_G = 1664, PC_PAD = 2176, PC_SQ = 2304, PC_SK = 2816, PC_SV = 3328, PC_SG = 3840;
constexpr int IN_COLS = 4224, SHIFT_COLS = 1664, NCHUNK = SEQ / 64;
constexpr size_t MiB = 1u << 20;
constexpr size_t WS_MODP = 0, WS_GATE = 786432, WS_W2T = 1 * MiB, WS_A2T = WS_W2T + 131072, WS_WIN = 2 * MiB, WS_WOUT = 19 * MiB, WS_GAM = 23 * MiB,
                 WS_H = 24 * MiB, WS_P = 56 * MiB, WS_D = 192 * MiB, WS_END = 256 * MiB;
constexpr int LDS_BYTES = 159744;
constexpr int NPHASE = 14;

struct Args { const float* in[19]; float* out; unsigned char* ws; int ph_lo, ph_hi; };

__device__ __forceinline__ unsigned f2bf(float f) { unsigned u = __builtin_bit_cast(unsigned, f); return (u + 0x7fffu + ((u >> 16) & 1u)) >> 16; }
__device__ __forceinline__ float bf2f(unsigned u) { return __builtin_bit_cast(float, u << 16); }
__device__ __forceinline__ unsigned pk2(float lo, float hi) { return pg8::cvt_pk_bf16(lo, hi); }
__device__ __forceinline__ f32x4 mfma16(bf16x8 a, bf16x8 b, f32x4 c) { return __builtin_amdgcn_mfma_f32_16x16x32_bf16(a, b, c, 0, 0, 0); }
__device__ __forceinline__ void unpack8(u32x4 w, float* o) {
    o[0] = bf2f(w.x & 0xffffu); o[1] = __builtin_bit_cast(float, w.x & 0xffff0000u); o[2] = bf2f(w.y & 0xffffu); o[3] = __builtin_bit_cast(float, w.y & 0xffff0000u);
    o[4] = bf2f(w.z & 0xffffu); o[5] = __builtin_bit_cast(float, w.z & 0xffff0000u); o[6] = bf2f(w.w & 0xffffu); o[7] = __builtin_bit_cast(float, w.w & 0xffff0000u); }
__device__ __forceinline__ f32x4 unpack4(u32x2 w) { f32x4 o; o[0] = bf2f(w.x & 0xffffu); o[1] = __builtin_bit_cast(float, w.x & 0xffff0000u); o[2] = bf2f(w.y & 0xffffu); o[3] = __builtin_bit_cast(float, w.y & 0xffff0000u); return o; }
__device__ __forceinline__ u32x2 pack4(f32x4 v) { u32x2 w; w.x = pk2(v[0], v[1]); w.y = pk2(v[2], v[3]); return w; }
__device__ __forceinline__ bf16x8 pack8(f32x4 a, f32x4 b) { u32x4 w; w.x = pk2(a[0], a[1]); w.y = pk2(a[2], a[3]); w.z = pk2(b[0], b[1]); w.w = pk2(b[2], b[3]); return __builtin_bit_cast(bf16x8, w); }
__device__ __forceinline__ float wave_sum(float v) {
#pragma unroll
    for (int o = 1; o < 64; o <<= 1) v += __shfl_xor(v, o);
    return v; }
#define WG_BAR() do { asm volatile("s_waitcnt vmcnt(0) lgkmcnt(0)" ::: "memory"); __builtin_amdgcn_s_barrier(); asm volatile("" ::: "memory"); } while (0)
#define LDS_BAR() do { asm volatile("s_waitcnt lgkmcnt(0)" ::: "memory"); __builtin_amdgcn_s_barrier(); asm volatile("" ::: "memory"); } while (0)
__device__ __forceinline__ f32x4 tile64(ldsp A, int arow, ldsp B, int brow, int q, f32x4 acc) {
#pragma unroll
    for (int ks = 0; ks < 2; ++ks) { const bf16x8 a = *(LAS const bf16x8*)(A + arow * 144 + ks * 64 + q * 16), b = *(LAS const bf16x8*)(B + brow * 144 + ks * 64 + q * 16); acc = mfma16(a, b, acc); }
    return acc; }

__device__ __forceinline__ void p0_transpose_item(const float* W, int K, int N, int src_n0, bf16_t* WT, int dst_n0, int k0, LAS float* scr, int lane) {
#pragma unroll 8
    for (int i = 0; i < 32; ++i) { const int kk = 2 * i + (lane >> 5); scr[kk * 33 + (lane & 31)] = src_n0 >= 0 ? W[(size_t)(k0 + kk) * N + src_n0 + (lane & 31)] : 0.f; }
    asm volatile("s_waitcnt lgkmcnt(0)" ::: "memory");
    const int c = lane & 7;
#pragma unroll
    for (int j = 0; j < 4; ++j) { const int n = (lane >> 3) + 8 * j; const LAS float* s = scr + (8 * c) * 33 + n;
        u32x4 o; o.x = pk2(s[0 * 33], s[1 * 33]); o.y = pk2(s[2 * 33], s[3 * 33]); o.z = pk2(s[4 * 33], s[5 * 33]); o.w = pk2(s[6 * 33], s[7 * 33]);
        *(u32x4*)(WT + (size_t)(dst_n0 + n) * K + k0 + 8 * c) = o; }
    asm volatile("s_waitcnt lgkmcnt(0)" ::: "memory");
}
__device__ __forceinline__ void phase_p0(const Args& a, ldsp lds, int tid, int lane, int wave, int G) {
    unsigned char* ws = a.ws;
    LAS float* scr = (LAS float*)(lds + wave * 16384);
    const int gw = blockIdx.x * 8 + wave, NGW = G * 8;
    constexpr int I_IN = 16 * (NPC / 32), I_OUT = 16 * (DM / 32), NITEMS = 2 * I_IN + 2 * I_OUT;
    for (int it = gw; it < NITEMS; it += NGW) {
        int r = it;
        if (r < 2 * I_IN) { const int l = r / I_IN; r -= l * I_IN; const int kb = r / (NPC / 32), nb = r % (NPC / 32); const int dn = 32 * nb;
            const int sn = dn < PC_PAD ? dn : (dn < PC_SQ ? -1 : dn - 128);
            p0_transpose_item(a.in[5] + (size_t)l * DM * IN_COLS, DM, IN_COLS, sn, (bf16_t*)(ws + WS_WIN) + (size_t)l * NPC * DM, dn, 64 * kb, scr, lane); }
        else { r -= 2 * I_IN; const int l = r / I_OUT; r -= l * I_OUT; const int kb = r / (DM / 32), nb = r % (DM / 32);
            p0_transpose_item(a.in[6] + (size_t)l * DM * DM, DM, DM, 32 * nb, (bf16_t*)(ws + WS_WOUT) + (size_t)l * DM * DM, 32 * nb, 64 * kb, scr, lane); }
    }
    { const int gt = blockIdx.x * 512 + tid, NT = G * 512;
      for (int o = gt; o < 2 * 65536; o += NT) { const int which = o >> 16, rem = o & 65535, l = rem >> 15, r2 = rem & 32767, n = r2 >> 6, m = r2 & 63;
          const float v = a.in[which ? 11 : 9][(size_t)(l * 64 + m) * 512 + n];
          ((bf16_t*)(ws + (which ? WS_A2T : WS_W2T)))[rem] = (bf16_t)f2bf(v); } }
    WG_BAR();
    LAS float* red = (LAS float*)lds;
    for (int unit = blockIdx.x; unit < 384; unit += G) {
        const int l = unit / 192, r = unit % 192, kp = r / 12, ncb = r % 12;
        const int n = ncb * 256 + (tid & 255), kh = tid >> 8, kbeg = kp * 64 + kh * 32;
        const float* W = a.in[3] + (size_t)l * DM * 3072 + n; const float* c0 = a.in[1]; const float* c1 = a.in[1] + DM;
        float a0 = 0.f, a1 = 0.f;
#pragma unroll 8
        for (int k = kbeg; k < kbeg + 32; ++k) { const float w = W[(size_t)k * 3072]; const float x0 = c0[k], x1 = c1[k];
            a0 += x0 / (1.f + __expf(-x0)) * w; a1 += x1 / (1.f + __expf(-x1)) * w; }
        if (kh == 1) { red[tid & 255] = a0; red[256 + (tid & 255)] = a1; }
        LDS_BAR();
        if (kh == 0) { float* mp = (float*)(ws + WS_MODP) + (size_t)((l * 16 + kp) * 2) * 3072 + n; mp[0] = a0 + red[tid]; mp[3072] = a1 + red[256 + tid]; }
        LDS_BAR();
    }
}

__device__ __forceinline__ void phase_h(const Args& a, ldsp lds, int l, const float* xin, int tid, int lane, int wave, int G) {
    unsigned char* ws = a.ws;
    LAS float* sc = (LAS float*)lds; LAS float* sh = sc + 2048;
    const float* modp = (const float*)(ws + WS_MODP) + (size_t)l * 16 * 2 * 3072; const float* adab = a.in[4] + l * 3072; const float* ng = a.in[2] + l * DM;
    for (int idx = tid; idx < 2048; idx += 512) { const int b = idx >> 10, k = idx & 1023; float s0 = adab[k], s1 = adab[1024 + k], s2 = adab[2048 + k];
        for (int kp = 0; kp < 16; ++kp) { const float* mp = modp + (size_t)(kp * 2 + b) * 3072; s0 += mp[k]; s1 += mp[1024 + k]; s2 += mp[2048 + k]; }
        sh[idx] = s0; sc[idx] = ng[k] * (1.f + s1);
        if (blockIdx.x == 0) ((float*)(ws + WS_GATE))[(l * 2 + b) * 1024 + k] = s2; }
    LDS_BAR();
    bf16_t* H = (bf16_t*)(ws + WS_H);
    const int gw = blockIdx.x * 8 + wave, NGW = G * 8;
    for (int m = gw; m < MROWS; m += NGW) {
        const f32x4* xr = (const f32x4*)(xin + (size_t)m * DM) + lane; const int b = m >> 13;
        f32x4 v[4]; float s = 0.f;
#pragma unroll
        for (int j = 0; j < 4; ++j) { v[j] = xr[64 * j]; s += (v[j][0] * v[j][0] + v[j][1] * v[j][1]) + (v[j][2] * v[j][2] + v[j][3] * v[j][3]); }
        const float rstd = 1.0f / sqrtf(wave_sum(s) * (1.f / DM) + 1e-6f);
        unsigned long long* o8 = (unsigned long long*)(H + (size_t)m * DM) + lane;
#pragma unroll
        for (int j = 0; j < 4; ++j) { const int k = 4 * lane + 256 * j; const f32x4 scv = *(LAS const f32x4*)(sc + b * 1024 + k), shv = *(LAS const f32x4*)(sh + b * 1024 + k);
            const f32x4 hv = v[j] * rstd * scv + shv; o8[64 * j] = (unsigned long long)pk2(hv[0], hv[1]) | ((unsigned long long)pk2(hv[2], hv[3]) << 32); }
    }
}
constexpr int L_RS = 0, L_KS = 16384, L_PB = 0, L_PTB = 9216, L_TB = 18432, L_TZW = 32768, L_ZA = 32768 + 9216, L_XT = 32768, L_C = 32768 + 18432;
constexpr int L_AG = L_C, L_RG = L_C + 9216, L_BG = L_C + 2 * 9216, L_KG = L_C + 3 * 9216, L_AGT = L_C + 4 * 9216, L_BTT = L_C + 5 * 9216, L_KTT = L_C + 6 * 9216, L_VT = L_C + 7 * 9216;
constexpr int L_D = L_C + 8 * 9216, L_AAK = L_D, L_ARB = L_D + 9216, L_ARK = L_D + 2 * 9216, L_MISC = L_D + 3 * 9216, L_AKVT = L_BG;
static_assert(L_MISC + 2048 <= LDS_BYTES, "R1 LDS map");
__device__ __forceinline__ float fexp(float x) { return __builtin_amdgcn_exp2f(x * 1.4426950408889634f); }
__device__ __forceinline__ float flog(float x) { return __builtin_amdgcn_logf(x) * 0.6931471805599453f; }
__device__ __forceinline__ float frcp(float x) { return __builtin_amdgcn_rcpf(x); }
__device__ __forceinline__ float tanh_f(float x) { return 1.f - 2.f * frcp(fexp(2.f * x) + 1.f); }
__device__ __forceinline__ void st16(ldsp p, float v) { *(LAS bf16_t*)p = (bf16_t)f2bf(v); }

#ifdef DBG_CHECK
constexpr size_t WS_DBG = 23 * MiB + 512 * 1024;
constexpr size_t WS_DUMP = WS_DBG + 256 * 1024;
__device__ __forceinline__ void dbg_dump(unsigned char* ws, ldsp lds, int l, int u, int tid, int ldsoff, int bytes, int dstoff) {
    if (l == 0 && u == 0) { for (int i = tid * 4; i < bytes; i += 2048) *(unsigned*)(ws + WS_DUMP + dstoff + i) = *(LAS const unsigned*)(lds + ldsoff + i); }
}
#define DBG_DUMP(ldsoff, bytes, dstoff) dbg_dump(ws, lds, l, u, tid, ldsoff, bytes, dstoff)
#else
#define DBG_DUMP(ldsoff, bytes, dstoff) do { } while (0)
#endif
__device__ __forceinline__ void r1_load(const Args& a, int l, int u, int tid, u32x4 (&rc)[5], u32x4 (&rp)[5]) {
    const int b = u >> 10, h = (u >> 7) & 7, c = u & 127, tt = tid >> 3, part = tid & 7, row = b * SEQ + c * 64 + tt; const bool hasprev = !(c == 0 && tt == 0);
    const bf16_t* prow = (const bf16_t*)(a.ws + WS_P) + (size_t)row * NPC; const bf16_t* pprev = prow - NPC;
    const int cols[5] = {PC_R + h * 64 + part * 8, PC_K + h * 64 + part * 8, PC_V + h * 64 + part * 8, PC_ZW + part * 8, PC_ZA + part * 8};
#pragma unroll
    for (int g = 0; g < 5; ++g) { rc[g] = *(const u32x4*)(prow + cols[g]); rp[g] = hasprev ? *(const u32x4*)(pprev + cols[g]) : (u32x4){0u, 0u, 0u, 0u}; }
}
__device__ __forceinline__ void r1_unit(const Args& a, ldsp lds, int l, int u, int unext, int tid, int lane, int wave, u32x4 (&rc)[5], u32x4 (&rp)[5]) {
    unsigned char* ws = a.ws;
    const int b = u >> 10, h = (u >> 7) & 7, c = u & 127, row0 = b * SEQ + c * 64, l15 = lane & 15, q = lane >> 4;
    bf16_t* P = (bf16_t*)(ws + WS_P);
    LAS float* RS = (LAS float*)(lds + L_RS); LAS float* KS = (LAS float*)(lds + L_KS);
    LAS float* rnorm = (LAS float*)(lds + L_MISC); LAS float* bonp = rnorm + 64;
    {
        const int tt = tid >> 3, part = tid & 7; const float* mu = a.in[7] + l * SHIFT_COLS;
        float cur[8], prv[8], ps[8];
#define R1_SHIFT(g, col) do { unpack8(rc[g], cur); unpack8(rp[g], prv); \
        const f32x4 m0 = *(const f32x4*)(mu + (col)), m1 = *(const f32x4*)(mu + (col) + 4); \
        _Pragma("unroll") for (int e = 0; e < 4; ++e) { ps[e] = cur[e] + (prv[e] - cur[e]) * m0[e]; ps[4 + e] = cur[4 + e] + (prv[4 + e] - cur[4 + e]) * m1[e]; } } while (0)
        R1_SHIFT(0, PC_R + h * 64 + part * 8);
        *(LAS f32x4*)(RS + tt * 64 + part * 8) = (f32x4){ps[0], ps[1], ps[2], ps[3]}; *(LAS f32x4*)(RS + tt * 64 + part * 8 + 4) = (f32x4){ps[4], ps[5], ps[6], ps[7]};
        R1_SHIFT(1, PC_K + h * 64 + part * 8);
        *(LAS f32x4*)(KS + tt * 64 + part * 8) = (f32x4){ps[0], ps[1], ps[2], ps[3]}; *(LAS f32x4*)(KS + tt * 64 + part * 8 + 4) = (f32x4){ps[4], ps[5], ps[6], ps[7]};
        { const float* kkp = a.in[12] + l * RWW + h * 64 + part * 8; float ss = 0.f;
#pragma unroll
          for (int e = 0; e < 8; ++e) { const float t = ps[e] * kkp[e]; ss += t * t; }
          ss += __shfl_xor(ss, 1); ss += __shfl_xor(ss, 2); ss += __shfl_xor(ss, 4);
          if (part == 0) rnorm[tt] = __builtin_amdgcn_rsqf(fmaxf(ss, 1e-24f)); }
        R1_SHIFT(2, PC_V + h * 64 + part * 8);
#pragma unroll
        for (int e = 0; e < 8; ++e) st16(lds + L_VT + (part * 8 + e) * 144 + tt * 2, ps[e]);
        R1_SHIFT(3, PC_ZW + part * 8);
        { u32x4 w; w.x = pk2(tanh_f(ps[0]), tanh_f(ps[1])); w.y = pk2(tanh_f(ps[2]), tanh_f(ps[3])); w.z = pk2(tanh_f(ps[4]), tanh_f(ps[5])); w.w = pk2(tanh_f(ps[6]), tanh_f(ps[7]));
          *(LAS u32x4*)(lds + L_TZW + tt * 144 + part * 16) = w; }
        R1_SHIFT(4, PC_ZA + part * 8);
        { u32x4 w; w.x = pk2(ps[0], ps[1]); w.y = pk2(ps[2], ps[3]); w.z = pk2(ps[4], ps[5]); w.w = pk2(ps[6], ps[7]); *(LAS u32x4*)(lds + L_ZA + tt * 144 + part * 16) = w; }
#undef R1_SHIFT
    }
    LDS_BAR();
    {
        const int ct = wave & 3, th = wave >> 2, jl = 16 * ct + l15, jg = h * 64 + jl;
        f32x4 wacc[2], aacc[2];
        { const bf16_t* w2t = (const bf16_t*)(ws + WS_W2T) + ((size_t)l * 512 + jg) * 64; const bf16_t* a2t = (const bf16_t*)(ws + WS_A2T) + ((size_t)l * 512 + jg) * 64;
          bf16x8 bw[2], ba[2];
#pragma unroll
          for (int ks = 0; ks < 2; ++ks) { bw[ks] = *(const bf16x8*)(w2t + 32 * ks + 8 * q); ba[ks] = *(const bf16x8*)(a2t + 32 * ks + 8 * q); }
#pragma unroll
          for (int m2 = 0; m2 < 2; ++m2) { const int mt = 2 * th + m2; wacc[m2] = (f32x4){0.f, 0.f, 0.f, 0.f}; aacc[m2] = (f32x4){0.f, 0.f, 0.f, 0.f};
#pragma unroll
              for (int ks = 0; ks < 2; ++ks) { const bf16x8 a1 = *(LAS const bf16x8*)(lds + L_TZW + (16 * mt + l15) * 144 + ks * 64 + q * 16), a2 = *(LAS const bf16x8*)(lds + L_ZA + (16 * mt + l15) * 144 + ks * 64 + q * 16);
                  wacc[m2] = mfma16(a1, bw[ks], wacc[m2]); aacc[m2] = mfma16(a2, ba[ks], aacc[m2]); } } }
        const float w0v = a.in[8][l * RWW + jg], a0v = a.in[10][l * RWW + jg], kkv = a.in[12][l * RWW + jg], kav = a.in[13][l * RWW + jg], rkv = a.in[14][l * RWW + jg];
        f32x4 ldv[2], cin[2]; float carry = 0.f;
#pragma unroll
        for (int m2 = 0; m2 < 2; ++m2) {
#pragma unroll
            for (int r = 0; r < 4; ++r) { const float wa = w0v + wacc[m2][r]; const float sp = fmaxf(-wa, 0.f) + flog(1.f + fexp(-fabsf(wa)));
                ldv[m2][r] = -fexp(-sp - 0.5f);
                aacc[m2][r] = frcp(1.f + fexp(-(a0v + aacc[m2][r]))); }
            const float p0 = ldv[m2][0], p1 = p0 + ldv[m2][1], p2 = p1 + ldv[m2][2], p3 = p2 + ldv[m2][3];
            const float t0 = __shfl(p3, l15), t1 = __shfl(p3, l15 + 16), t2 = __shfl(p3, l15 + 32), t3 = __shfl(p3, l15 + 48);
            const float base = carry + (q > 0 ? t0 : 0.f) + (q > 1 ? t1 : 0.f) + (q > 2 ? t2 : 0.f);
            cin[m2] = (f32x4){base + p0, base + p1, base + p2, base + p3}; carry += (t0 + t1) + (t2 + t3);
        }
        LAS float* htot = (LAS float*)(lds + L_MISC + 1536);
        if (q == 0) htot[th * 64 + jl] = carry;
        LDS_BAR();
        const float lo_ = htot[jl], hi_ = htot[64 + jl], ctot = lo_ + hi_, base0 = th ? lo_ : 0.f;
#pragma unroll
        for (int m2 = 0; m2 < 2; ++m2) { const int mt = 2 * th + m2; f32x4 agt, btt, ktt;
#pragma unroll
            for (int r = 0; r < 4; ++r) { const int t = 16 * mt + 4 * q + r; const float rr = RS[t * 64 + jl], kr = KS[t * 64 + jl], rn = rnorm[t];
                const float kk = kr * kkv * rn, av = aacc[m2][r], bq = kk * av, kp = kr * (1.f + (av - 1.f) * kav);
                const float ci = cin[m2][r] + base0, e_in = fexp(ci), e_ex = fexp(ci - ldv[m2][r]), e_ni = fexp(-ci), e_t = fexp(ctot - ci);
                const float Ag = -kk * e_ex, Rg = rr * e_in, Bg = bq * e_ni, Kg = kp * e_ni; agt[r] = Ag; btt[r] = bq * e_t; ktt[r] = kp * e_t;
                st16(lds + L_AG + t * 144 + jl * 2, Ag); st16(lds + L_RG + t * 144 + jl * 2, Rg); st16(lds + L_BG + t * 144 + jl * 2, Bg); st16(lds + L_KG + t * 144 + jl * 2, Kg);
                float bon = rr * kp * rkv; bon += __shfl_xor(bon, 1); bon += __shfl_xor(bon, 2); bon += __shfl_xor(bon, 4); bon += __shfl_xor(bon, 8);
                if (l15 == 0) bonp[ct * 64 + t] = bon; }
            *(LAS u32x2*)(lds + L_AGT + jl * 144 + (16 * mt + 4 * q) * 2) = pack4(agt); *(LAS u32x2*)(lds + L_BTT + jl * 144 + (16 * mt + 4 * q) * 2) = pack4(btt);
            *(LAS u32x2*)(lds + L_KTT + jl * 144 + (16 * mt + 4 * q) * 2) = pack4(ktt); }
        if (th == 0 && q == 0) ((float*)(ws + WS_GAM))[(size_t)u * 64 + jl] = fexp(ctot);
    }
    LDS_BAR();
    if (unext >= 0) r1_load(a, l, unext, tid, rc, rp);
    DBG_DUMP(L_C, 73728, 0);
    if (tid < 64) { const float bs = (bonp[tid] + bonp[64 + tid]) + (bonp[128 + tid] + bonp[192 + tid]); *(float*)((unsigned char*)(P + (size_t)(row0 + tid) * NPC + PC_PAD) + h * 4) = bs; }
    { const int blk = wave & 3, half = wave >> 2; const int aoff = (blk & 1) ? L_KG : L_BG, boff = (blk & 2) ? L_RG : L_AG;
      const int dest = blk == 0 ? L_PB : (blk == 1 ? L_AAK : (blk == 2 ? L_ARB : L_ARK));
#pragma unroll 1
      for (int i = 0; i < 8; ++i) { const int ti = 2 * i + half, mt = ti >> 2, nt = ti & 3; f32x4 acc = (f32x4){0.f, 0.f, 0.f, 0.f};
          if (mt <= nt) acc = tile64(lds + aoff, 16 * mt + l15, lds + boff, 16 * nt + l15, q, acc);
          const int t = 16 * nt + l15, tb = 16 * mt + 4 * q;
#pragma unroll
          for (int r = 0; r < 4; ++r) { const bool keep = (blk < 2) ? (tb + r < t) : (tb + r <= t); acc[r] = keep ? acc[r] : 0.f; }
          *(LAS u32x2*)(lds + dest + t * 144 + tb * 2) = pack4(acc);
          if (blk == 0) {
#pragma unroll
              for (int r = 0; r < 4; ++r) st16(lds + L_PTB + (tb + r) * 144 + t * 2, acc[r]); } } }
    LDS_BAR();
    DBG_DUMP(L_PB, 18432, 73728); DBG_DUMP(L_D, 27648, 73728 + 18432);
#pragma unroll
    for (int i = 0; i < 2; ++i) { const int id = wave * 2 + i, mt = id >> 2, nt = id & 3; f32x4 acc = (f32x4){0.f, 0.f, 0.f, 0.f};
        acc = tile64(lds + L_AAK, 16 * mt + l15, lds + L_VT, 16 * nt + l15, q, acc);
        *(LAS u32x2*)(lds + L_AKVT + (16 * nt + l15) * 144 + (16 * mt + 4 * q) * 2) = pack4(acc); }
#ifdef DBG_CHECK
    LDS_BAR(); DBG_DUMP(L_AKVT, 9216, -49152); LDS_BAR();
#endif
    { const int mt = wave >> 1; f32x4 Tacc[2], Pn[2];
#pragma unroll
      for (int i = 0; i < 2; ++i) { const int nt = 2 * (wave & 1) + i, tau = 16 * nt + l15;
#pragma unroll
          for (int r = 0; r < 4; ++r) { const int t = 16 * mt + 4 * q + r; Tacc[i][r] = bf2f(*(LAS const bf16_t*)(lds + L_PB + t * 144 + tau * 2)) + (t == tau ? 1.f : 0.f); } }
      for (int round = 0; round < 5; ++round) {
#pragma unroll
          for (int i = 0; i < 2; ++i) { const int nt = 2 * (wave & 1) + i; Pn[i] = (f32x4){0.f, 0.f, 0.f, 0.f};
              if (nt <= mt) Pn[i] = tile64(lds + L_PB, 16 * mt + l15, lds + L_PTB, 16 * nt + l15, q, Pn[i]); }
          LDS_BAR();
#pragma unroll
          for (int i = 0; i < 2; ++i) { const int nt = 2 * (wave & 1) + i, tau = 16 * nt + l15;
#pragma unroll
              for (int r = 0; r < 4; ++r) { const int t = 16 * mt + 4 * q + r; st16(lds + L_PB + t * 144 + tau * 2, Pn[i][r]); st16(lds + L_TB + t * 144 + tau * 2, Tacc[i][r]); }
              *(LAS u32x2*)(lds + L_PTB + tau * 144 + (16 * mt + 4 * q) * 2) = pack4(Pn[i]); }
          LDS_BAR();
#pragma unroll
          for (int i = 0; i < 2; ++i) { const int nt = 2 * (wave & 1) + i; if (nt <= mt) Tacc[i] = tile64(lds + L_TB, 16 * mt + l15, lds + L_PTB, 16 * nt + l15, q, Tacc[i]); }
      }
      LDS_BAR();
#pragma unroll
      for (int i = 0; i < 2; ++i) { const int nt = 2 * (wave & 1) + i, tau = 16 * nt + l15;
#pragma unroll
          for (int r = 0; r < 4; ++r) { const int t = 16 * mt + 4 * q + r; st16(lds + L_TB + t * 144 + tau * 2, Tacc[i][r]); } }
    }
    LDS_BAR();
    DBG_DUMP(L_TB, 9216, 119808); DBG_DUMP(L_AKVT, 9216, 129024);
#pragma unroll 1
    for (int i = 0; i < 4; ++i) { const int id = wave * 4 + i, mt = id & 3, nt = id >> 2; f32x4 acc = (f32x4){0.f, 0.f, 0.f, 0.f};
        acc = tile64(lds + L_TB, 16 * mt + l15, nt < 4 ? lds + L_AGT : lds + L_AKVT, 16 * (nt & 3) + l15, q, acc);
        *(LAS u32x2*)(lds + L_XT + (16 * nt + l15) * 144 + (16 * mt + 4 * q) * 2) = pack4(acc); }
    LDS_BAR();
    DBG_DUMP(L_XT, 18432, 138240);
    { unsigned char* Du = ws + WS_D + (size_t)u * 32768; const int kind = wave >> 1;
#pragma unroll 1
      for (int i = 0; i < 8; ++i) { const int id = (wave & 1) * 8 + i, mt = id & 3, nt = id >> 2; f32x4 acc = (f32x4){0.f, 0.f, 0.f, 0.f}; const int row = 16 * nt + l15;
          if (kind == 0) { acc = tile64(lds + L_XT, 16 * mt + l15, lds + L_BTT, row, q, acc); }
          else if (kind == 1) { acc = tile64(lds + L_XT, 16 * mt + l15, lds + L_ARB, row, q, acc); acc += unpack4(*(LAS const u32x2*)(lds + L_RG + row * 144 + (16 * mt + 4 * q) * 2)); }
          else if (kind == 2) { acc = tile64(lds + L_BTT, 16 * mt + l15, lds + L_XT, 64 + row, q, acc); acc = tile64(lds + L_KTT, 16 * mt + l15, lds + L_VT, row, q, acc); }
          else { acc = tile64(lds + L_XT, 64 + 16 * mt + l15, lds + L_ARB, row, q, acc); acc = tile64(lds + L_VT, 16 * mt + l15, lds + L_ARK, row, q, acc); }
          const int sw = (row >> 1) & 7;
          const int off = kind < 2 ? row * 128 + (((4 * (mt >> 1) + q) ^ sw) * 16) + 8 * (mt & 1) : row * 128 + (((2 * mt + (q >> 1)) ^ sw) * 16) + 8 * (q & 1);
          *(u32x2*)(Du + kind * 8192 + off) = pack4(acc); } }
    LDS_BAR();
}

__device__ __forceinline__ void sb_task(const Args& a, ldsp vs, int l, int task, int lane) {
    unsigned char* ws = a.ws; const bf16_t* P = (const bf16_t*)(ws + WS_P); bf16_t* Y = (bf16_t*)(ws + WS_H);
    const int bh = task >> 8, qt = task & 255, b = bh >> 3, h = bh & 7, q0 = qt * 32, rowb = b * SEQ, l15 = lane & 15, q = lane >> 4;
    bf16x8 bq[2][2];
#pragma unroll
    for (int qi = 0; qi < 2; ++qi)
#pragma unroll
        for (int ks = 0; ks < 2; ++ks) bq[qi][ks] = *(const bf16x8*)(P + (size_t)(rowb + q0 + 16 * qi + l15) * NPC + PC_SQ + h * 64 + 32 * ks + 8 * q);
    bf16x8 am[2];
#pragma unroll
    for (int mt = 0; mt < 2; ++mt)
#pragma unroll
        for (int e = 0; e < 8; ++e) am[mt][e] = ((16 * (e >> 2) + 4 * q + (e & 3)) > (16 * mt + l15)) ? (short)0x3F80 : (short)0;
    f32x4 O[2][4];
#pragma unroll
    for (int qi = 0; qi < 2; ++qi)
#pragma unroll
        for (int nt = 0; nt < 4; ++nt) O[qi][nt] = (f32x4){0.f, 0.f, 0.f, 0.f};
    float carry[2] = {0.f, 0.f};
    int kb = qt;
    bf16x8 kA[2][2], kN[2][2]; u32x4 vR[4], vN[4];
#define SB_LOAD(KA, VR, kbv) do { _Pragma("unroll") for (int mt = 0; mt < 2; ++mt) _Pragma("unroll") for (int ks = 0; ks < 2; ++ks) \
        KA[mt][ks] = *(const bf16x8*)(P + (size_t)(rowb + 32 * (kbv) + 16 * mt + l15) * NPC + PC_SK + h * 64 + 32 * ks + 8 * q); \
        _Pragma("unroll") for (int i = 0; i < 4; ++i) { const int pi = lane + 64 * i; VR[i] = *(const u32x4*)(P + (size_t)(rowb + 32 * (kbv) + (pi >> 3)) * NPC + PC_SV + h * 64 + (pi & 7) * 8); } } while (0)
    SB_LOAD(kA, vR, kb);
    for (;;) {
#pragma unroll
        for (int i = 0; i < 4; ++i) { const int pi = lane + 64 * i; *(LAS u32x4*)(vs + (pi >> 3) * 144 + (pi & 7) * 16) = vR[i]; }
        if (kb > 0) SB_LOAD(kN, vN, kb - 1);
        bf16x8 Wop[2];
#pragma unroll
        for (int qi = 0; qi < 2; ++qi) { const int t = q0 + 16 * qi + l15;
            f32x4 ell[2], lsz[2]; bool valid[2][4];
#pragma unroll
            for (int mt = 0; mt < 2; ++mt) { f32x4 z = (f32x4){0.f, 0.f, 0.f, 0.f}; z = mfma16(kA[mt][0], bq[qi][0], z); z = mfma16(kA[mt][1], bq[qi][1], z);
#pragma unroll
                for (int r = 0; r < 4; ++r) { const int s = 32 * kb + 16 * mt + 4 * q + r; const float zz = z[r] * 0.125f; const float sp = fmaxf(zz, 0.f) + flog(1.f + fexp(-fabsf(zz)));
                    valid[mt][r] = s < t; ell[mt][r] = valid[mt][r] ? -sp : 0.f; lsz[mt][r] = zz - sp; } }
            const bf16x8 Lhi = pack8(ell[0], ell[1]);
            f32x4 lo0, lo1; { const u32x4 w = __builtin_bit_cast(u32x4, Lhi);
                lo0[0] = ell[0][0] - bf2f(w.x & 0xffffu); lo0[1] = ell[0][1] - __builtin_bit_cast(float, w.x & 0xffff0000u); lo0[2] = ell[0][2] - bf2f(w.y & 0xffffu); lo0[3] = ell[0][3] - __builtin_bit_cast(float, w.y & 0xffff0000u);
                lo1[0] = ell[1][0] - bf2f(w.z & 0xffffu); lo1[1] = ell[1][1] - __builtin_bit_cast(float, w.z & 0xffff0000u); lo1[2] = ell[1][2] - bf2f(w.w & 0xffffu); lo1[3] = ell[1][3] - __builtin_bit_cast(float, w.w & 0xffff0000u); }
            const bf16x8 Llo = pack8(lo0, lo1);
            f32x4 aft[2], wv[2];
#pragma unroll
            for (int mt = 0; mt < 2; ++mt) { aft[mt] = (f32x4){0.f, 0.f, 0.f, 0.f}; aft[mt] = mfma16(am[mt], Lhi, aft[mt]); aft[mt] = mfma16(am[mt], Llo, aft[mt]);
#pragma unroll
                for (int r = 0; r < 4; ++r) wv[mt][r] = valid[mt][r] ? fexp(lsz[mt][r] + aft[mt][r] + carry[qi]) : 0.f; }
            carry[qi] += __shfl(aft[0][0] + ell[0][0], l15);
            Wop[qi] = pack8(wv[0], wv[1]); }
        {
          typedef short s16x4 __attribute__((ext_vector_type(4)));
          s16x4 v00, v01, v10, v11, v20, v21, v30, v31;
          const unsigned va = (unsigned)(size_t)(vs + (4 * q + (l15 >> 2)) * 144 + 8 * (lane & 3));
          asm volatile("s_waitcnt lgkmcnt(0)\n\tds_read_b64_tr_b16 %0, %8\n\tds_read_b64_tr_b16 %1, %8 offset:2304\n\tds_read_b64_tr_b16 %2, %8 offset:32\n\tds_read_b64_tr_b16 %3, %8 offset:2336\n\t"
                       "ds_read_b64_tr_b16 %4, %8 offset:64\n\tds_read_b64_tr_b16 %5, %8 offset:2368\n\tds_read_b64_tr_b16 %6, %8 offset:96\n\tds_read_b64_tr_b16 %7, %8 offset:2400\n\ts_waitcnt lgkmcnt(0)"
                       : "=&v"(v00), "=&v"(v01), "=&v"(v10), "=&v"(v11), "=&v"(v20), "=&v"(v21), "=&v"(v30), "=&v"(v31) : "v"(va) : "memory");
          const bf16x8 vb0 = __builtin_shufflevector(v00, v01, 0, 1, 2, 3, 4, 5, 6, 7), vb1 = __builtin_shufflevector(v10, v11, 0, 1, 2, 3, 4, 5, 6, 7), vb2 = __builtin_shufflevector(v20, v21, 0, 1, 2, 3, 4, 5, 6, 7), vb3 = __builtin_shufflevector(v30, v31, 0, 1, 2, 3, 4, 5, 6, 7);
#pragma unroll
          for (int qi = 0; qi < 2; ++qi) { O[qi][0] = mfma16(Wop[qi], vb0, O[qi][0]); O[qi][1] = mfma16(Wop[qi], vb1, O[qi][1]); O[qi][2] = mfma16(Wop[qi], vb2, O[qi][2]); O[qi][3] = mfma16(Wop[qi], vb3, O[qi][3]); } }
        if (kb == 0) break;
        if (__all(carry[0] < -100.f && carry[1] < -100.f)) break;
        --kb;
#pragma unroll
        for (int mt = 0; mt < 2; ++mt)
#pragma unroll
            for (int ks = 0; ks < 2; ++ks) kA[mt][ks] = kN[mt][ks];
#pragma unroll
        for (int i = 0; i < 4; ++i) vR[i] = vN[i];
    }
#undef SB_LOAD
    const float* sbg = a.in[17] + l * 512 + h * 64;
#pragma unroll
    for (int qi = 0; qi < 2; ++qi)
#pragma unroll
    for (int r = 0; r < 4; ++r) { float ss = (O[qi][0][r] * O[qi][0][r] + O[qi][1][r] * O[qi][1][r]) + (O[qi][2][r] * O[qi][2][r] + O[qi][3][r] * O[qi][3][r]);
        ss += __shfl_xor(ss, 1); ss += __shfl_xor(ss, 2); ss += __shfl_xor(ss, 4); ss += __shfl_xor(ss, 8);
        const float rms = __builtin_amdgcn_rsqf(ss * (1.f / 64.f) + 1e-6f); const int tq = q0 + 16 * qi + 4 * q + r;
        const size_t row = (size_t)(rowb + ((tq & 127) << 6) + (tq >> 7));
#pragma unroll
        for (int nt = 0; nt < 4; ++nt) { const int d = 16 * nt + l15; const float g = bf2f(P[row * NPC + PC_SG + h * 64 + d]);
            float yv = O[qi][nt][r] * rms * sbg[d] * (g * frcp(1.f + fexp(-g)));
            Y[row * DM + 512 + h * 64 + d] = (bf16_t)f2bf(yv); } }
}

constexpr int R2_SLOT = 10496, R2_NS = 12, R2_PD = 10;
__device__ __forceinline__ void phase_r2(const Args& a, ldsp lds, int tid, int lane, int wave) {
    unsigned char* ws = a.ws; const int bh = blockIdx.x >> 2, ig = blockIdx.x & 3, b = bh >> 3, h = bh & 7, u0 = bh * NCHUNK, l15 = lane & 15, q = lane >> 4;
    const unsigned char* Dg = ws + WS_D + (size_t)u0 * 32768; const unsigned char* Gg = ws + WS_GAM + (size_t)u0 * 256;
    if (wave == 1) {
#define R2_ISSUE_A(cc) do { const int c_ = (cc) < NCHUNK ? (cc) : NCHUNK - 1; const int sl_ = ((cc) % R2_NS) * R2_SLOT; _Pragma("unroll") for (int i = 0; i < 6; ++i) \
        __builtin_amdgcn_global_load_lds((const unsigned*)(Dg + (size_t)c_ * 32768 + i * 1024 + lane * 16), (LAS unsigned*)(lds + sl_ + i * 1024), 16, 0, 0); } while (0)
        for (int c = 0; c < R2_PD; ++c) R2_ISSUE_A(c);
        asm volatile("s_waitcnt vmcnt(54)" ::: "memory");
        __builtin_amdgcn_s_barrier();
        for (int c = 0; c < NCHUNK; ++c) { R2_ISSUE_A(c + R2_PD); asm volatile("s_waitcnt vmcnt(54)" ::: "memory"); __builtin_amdgcn_s_barrier(); }
        asm volatile("s_waitcnt vmcnt(0)" ::: "memory");
#undef R2_ISSUE_A
    } else if (wave == 2) {
#define R2_ISSUE_B(cc) do { const int c_ = (cc) < NCHUNK ? (cc) : NCHUNK - 1; const int sl_ = ((cc) % R2_NS) * R2_SLOT; const unsigned char* du_ = Dg + (size_t)c_ * 32768; \
        __builtin_amdgcn_global_load_lds((const unsigned*)(du_ + 6 * 1024 + lane * 16), (LAS unsigned*)(lds + sl_ + 6 * 1024), 16, 0, 0); \
        __builtin_amdgcn_global_load_lds((const unsigned*)(du_ + 7 * 1024 + lane * 16), (LAS unsigned*)(lds + sl_ + 7 * 1024), 16, 0, 0); \
        __builtin_amdgcn_global_load_lds((const unsigned*)(du_ + 16384 + ig * 2048 + lane * 16), (LAS unsigned*)(lds + sl_ + 8192), 16, 0, 0); \
        __builtin_amdgcn_global_load_lds((const unsigned*)(du_ + 16384 + ig * 2048 + 1024 + lane * 16), (LAS unsigned*)(lds + sl_ + 9216), 16, 0, 0); \
        if (lane < 16) __builtin_amdgcn_global_load_lds((const unsigned*)(Gg + (size_t)c_ * 256 + lane * 16), (LAS unsigned*)(lds + sl_ + 10240), 16, 0, 0); } while (0)
        for (int c = 0; c < R2_PD; ++c) R2_ISSUE_B(c);
        asm volatile("s_waitcnt vmcnt(45)" ::: "memory");
        __builtin_amdgcn_s_barrier();
        for (int c = 0; c < NCHUNK; ++c) { R2_ISSUE_B(c + R2_PD); asm volatile("s_waitcnt vmcnt(45)" ::: "memory"); __builtin_amdgcn_s_barrier(); }
        asm volatile("s_waitcnt vmcnt(0)" ::: "memory");
#undef R2_ISSUE_B
    } else if (wave == 0) {
        const int swi = (l15 >> 1) & 7;
        unsigned char* sg = ws + WS_P + (size_t)(b * SEQ + 16 * ig + l15) * (NPC * 2) + h * 128 + 16 * q;
        f32x4 S[4];
#pragma unroll
        for (int mt = 0; mt < 4; ++mt) S[mt] = (f32x4){0.f, 0.f, 0.f, 0.f};
        asm volatile("" ::: "memory"); __builtin_amdgcn_s_barrier(); asm volatile("" ::: "memory");
        for (int c = 0; c < NCHUNK; ++c) {
            ldsp slot = lds + (c % R2_NS) * R2_SLOT;
            bf16x8 sb[2]; sb[0] = pack8(S[0], S[1]); sb[1] = pack8(S[2], S[3]);
            { unsigned char* sp = sg + (size_t)c * 64 * (NPC * 2); *(bf16x8*)sp = sb[0]; *(bf16x8*)(sp + 64) = sb[1]; }
            f32x4 aS[4];
#pragma unroll
            for (int mt = 0; mt < 4; ++mt) { const int po = l15 * 128 + (((2 * mt + (q >> 1)) ^ swi) * 16) + 8 * (q & 1);
                aS[mt] = *(LAS const f32x4*)(slot + 10240 + (16 * mt + 4 * q) * 4) * S[mt] + unpack4(*(LAS const u32x2*)(slot + 8192 + po)); }
#pragma unroll
            for (int ks = 0; ks < 2; ++ks)
#pragma unroll
                for (int mt = 0; mt < 4; ++mt) { const int jr = 16 * mt + l15; const bf16x8 pa = *(LAS const bf16x8*)(slot + jr * 128 + (((4 * ks + q) ^ ((jr >> 1) & 7)) * 16)); aS[mt] = mfma16(pa, sb[ks], aS[mt]); }
#pragma unroll
            for (int mt = 0; mt < 4; ++mt) S[mt] = aS[mt];
            asm volatile("s_waitcnt lgkmcnt(0)" ::: "memory"); __builtin_amdgcn_s_barrier(); asm volatile("" ::: "memory");
        }
    } else {
        for (int c = 0; c <= NCHUNK; ++c) __builtin_amdgcn_s_barrier();
    }
    WG_BAR();
}

__device__ __forceinline__ void r3_task(const Args& a, int l, int task, int lane) {
    unsigned char* ws = a.ws; const bf16_t* P = (const bf16_t*)(ws + WS_P); bf16_t* Y = (bf16_t*)(ws + WS_H);
    const int u = task >> 2, tt = task & 3, b = u >> 10, h = (u >> 7) & 7, c = u & 127, row0 = b * SEQ + c * 64, l15 = lane & 15, q = lane >> 4;
    const unsigned char* Du = ws + WS_D + (size_t)u * 32768;
    const int tl = 16 * tt + l15, row = row0 + tl, swt = (tl >> 1) & 7;
    bf16x8 rb[2];
#pragma unroll
    for (int ks = 0; ks < 2; ++ks) rb[ks] = *(const bf16x8*)(Du + 8192 + tl * 128 + (((4 * ks + q) ^ swt) * 16));
    f32x4 acc[4];
#pragma unroll
    for (int mt = 0; mt < 4; ++mt) { const int i = 16 * mt + l15; const unsigned char* sp = (const unsigned char*)P + (size_t)(row0 + i) * (NPC * 2) + h * 128 + 16 * q;
        const bf16x8 s0 = *(const bf16x8*)sp, s1 = *(const bf16x8*)(sp + 64);
        acc[mt] = unpack4(*(const u32x2*)(Du + 24576 + tl * 128 + (((2 * mt + (q >> 1)) ^ swt) * 16) + 8 * (q & 1)));
        acc[mt] = mfma16(s0, rb[0], acc[mt]); acc[mt] = mfma16(s1, rb[1], acc[mt]); }
    float s = 0.f;
#pragma unroll
    for (int mt = 0; mt < 4; ++mt) s += (acc[mt][0] + acc[mt][1]) + (acc[mt][2] + acc[mt][3]);
    s += __shfl_xor(s, 16); s += __shfl_xor(s, 32);
    const float mean = s * (1.f / 64.f); float v = 0.f;
#pragma unroll
    for (int mt = 0; mt < 4; ++mt) { acc[mt] = acc[mt] - mean; v += (acc[mt][0] * acc[mt][0] + acc[mt][1] * acc[mt][1]) + (acc[mt][2] * acc[mt][2] + acc[mt][3] * acc[mt][3]); }
    v += __shfl_xor(v, 16); v += __shfl_xor(v, 32);
    const float rstd = __builtin_amdgcn_rsqf(v * (1.f / 64.f) + 64e-5f);
    const bf16_t* pr = P + (size_t)row * NPC; const float bon = *(const float*)((const unsigned char*)pr + PC_PAD * 2 + h * 4); const bool hasprev = (row & (SEQ - 1)) != 0;
    const float* lnw = a.in[15] + l * RWW + h * 64; const float* lnb = a.in[16] + l * RWW + h * 64; const float* mu = a.in[7] + l * SHIFT_COLS + PC_V + h * 64;
#pragma unroll
    for (int mt = 0; mt < 4; ++mt) { const int i0 = 16 * mt + 4 * q;
        const f32x4 vc = unpack4(*(const u32x2*)(pr + PC_V + h * 64 + i0)), vp = hasprev ? unpack4(*(const u32x2*)(pr + PC_V + h * 64 + i0 - NPC)) : (f32x4){0.f, 0.f, 0.f, 0.f}, g = unpack4(*(const u32x2*)(pr + PC_G + h * 64 + i0));
        const f32x4 wv = *(const f32x4*)(lnw + i0), bv = *(const f32x4*)(lnb + i0), mv = *(const f32x4*)(mu + i0);
        const f32x4 vs = vc + (vp - vc) * mv; f32x4 o = acc[mt] * rstd * wv + bv + bon * vs;
#pragma unroll
        for (int r = 0; r < 4; ++r) o[r] = o[r] * g[r] * frcp(1.f + fexp(-g[r]));
        *(u32x2*)(Y + (size_t)row * DM + h * 64 + i0) = pack4(o); }
}

__device__ __forceinline__ void phase_final(const Args& a, int lane, int wave, int G) {
    const int gw = blockIdx.x * 8 + wave, NGW = G * 8; const float* fg = a.in[18];
    for (int m = gw; m < MROWS; m += NGW) {
        f32x4* xr = (f32x4*)(a.out + (size_t)m * DM) + lane; f32x4 v[4]; float s = 0.f;
#pragma unroll
        for (int j = 0; j < 4; ++j) { v[j] = xr[64 * j]; s += (v[j][0] * v[j][0] + v[j][1] * v[j][1]) + (v[j][2] * v[j][2] + v[j][3] * v[j][3]); }
        const float rstd = 1.0f / sqrtf(wave_sum(s) * (1.f / DM) + 1e-6f);
#pragma unroll
        for (int j = 0; j < 4; ++j) { const f32x4 g = *(const f32x4*)(fg + 4 * lane + 256 * j); xr[64 * j] = v[j] * rstd * g; }
    }
}

#define XB_TMO      128
#define XB_XCNT(j)  (256  + 64 * (j))
#define XB_XSUB(j)  (1280 + 64 * (j))
#define XB_XGEN(j)  (2304 + 64 * (j))
#define XB_TOP      3328
#define XB_TOPGEN   3392
#define XCD_BAR_WORDS 3456
#define XB_SPIN_CAP (1u << 18)

__device__ __forceinline__ unsigned xb_ld(unsigned* p)              { return __hip_atomic_load(p, __ATOMIC_RELAXED, __HIP_MEMORY_SCOPE_AGENT); }
__device__ __forceinline__ unsigned xb_add(unsigned* p, unsigned v) { return __hip_atomic_fetch_add(p, v, __ATOMIC_RELAXED, __HIP_MEMORY_SCOPE_AGENT); }
__device__ __forceinline__ unsigned xb_xcc_id() { return (unsigned)__builtin_amdgcn_s_getreg((3 << 11) | 20) & 0xFu; }
#define XB_SPIN(cond, bar) do { unsigned _sp = 0; while (cond) { __builtin_amdgcn_s_sleep(1); \
    if ((++_sp & 255u) == 0u) { if (xb_ld(&(bar)[XB_TMO])) break; if (_sp > XB_SPIN_CAP) { atomicAdd(&(bar)[XB_TMO], 1u); break; } } } } while (0)

struct XcdBarrier {
    unsigned* bar; unsigned x;
    volatile LAS unsigned* st;
};

__device__ __forceinline__ XcdBarrier xcd_barrier_post(unsigned* bar, volatile LAS unsigned* st) {
    XcdBarrier b; b.bar = bar; b.x = xb_xcc_id(); b.st = st;
    if (threadIdx.x == 0) (void)xb_add(&bar[XB_XCNT(b.x)], 1u);
    return b;
}
__device__ __forceinline__ void xcd_barrier_complete(unsigned* bar, unsigned x, unsigned& nloc, unsigned& nx) {
    const unsigned G = gridDim.x * gridDim.y * gridDim.z;
    unsigned sum, cnt, mine, sp = 0u;
    for (;;) {
        sum = 0u; cnt = 0u; mine = 0u;
#pragma unroll
        for (unsigned j = 0; j < 16; ++j) { const unsigned c = xb_ld(&bar[XB_XCNT(j)]); sum += c; cnt += (c > 0u) ? 1u : 0u; mine = (j == x) ? c : mine; }
        if (sum == G) break;
        __builtin_amdgcn_s_sleep(1);
        if ((++sp & 255u) == 0u) { if (xb_ld(&bar[XB_TMO])) break; if (sp > XB_SPIN_CAP) { atomicAdd(&bar[XB_TMO], 1u); break; } }
    }
    nloc = mine > 0u ? mine : 1u; nx = cnt > 0u ? cnt : 1u;
}

__device__ __forceinline__ void xcd_barrier(const XcdBarrier& b) {
    asm volatile("s_waitcnt vmcnt(0)" ::: "memory");
    __syncthreads();
    if (threadIdx.x == 0) {
        unsigned* bar = b.bar;
        __builtin_amdgcn_s_waitcnt(0);
        unsigned nloc = b.st[0], nx = b.st[1];
        if (nloc == 0u) { xcd_barrier_complete(bar, b.x, nloc, nx); b.st[0] = nloc; b.st[1] = nx; }
        const unsigned old = xb_add(&bar[XB_XSUB(b.x)], 1u);
        const unsigned gen = old / nloc;
        if (old + 1u == (gen + 1u) * nloc) {
            __builtin_amdgcn_fence(__ATOMIC_RELEASE, "agent");
            asm volatile("s_waitcnt vmcnt(0)" ::: "memory");
            const unsigned og = xb_add(&bar[XB_TOP], 1u);
            const unsigned tg = og / nx;
            if (og + 1u == (tg + 1u) * nx) xb_add(&bar[XB_TOPGEN], 1u);
            else XB_SPIN(xb_ld(&bar[XB_TOPGEN]) == tg, bar);
            __builtin_amdgcn_fence(__ATOMIC_ACQUIRE, "agent");
            xb_add(&bar[XB_XGEN(b.x)], 1u);
            asm volatile("s_waitcnt vmcnt(0)" ::: "memory");
        } else {
            XB_SPIN(xb_ld(&bar[XB_XGEN(b.x)]) == gen, bar);
            __builtin_amdgcn_fence(__ATOMIC_ACQUIRE, "agent");
            asm volatile("s_waitcnt vmcnt(0)" ::: "memory");
        }
    }
    __syncthreads();
}

#ifndef MK_PER_PHASE
#define MK_PER_PHASE 0
#endif
#ifndef PHMASK
#define PHMASK 0x1ff
#endif
#ifndef DUPMASK
#define DUPMASK 0
#endif
#if MK_PER_PHASE
#define RUN(k) (a.ph_lo <= (k) && (k) < a.ph_hi)
#define SEAM(k) do { } while (0)
#else
#define RUN(k) true
#define SEAM(k) xcd_barrier(bar)
#endif
__global__ void __launch_bounds__(512, 2) fwd_kernel(Args a) {
    extern __shared__ __attribute__((aligned(16))) unsigned char lds_raw[];
    ldsp lds = (ldsp)lds_raw;
    cg::grid_group grid = cg::this_grid();
    int tid = threadIdx.x, lane = tid & 63, wave = __builtin_amdgcn_readfirstlane(tid >> 6); const int G = gridDim.x;
#define FRESH() do { tid = threadIdx.x; asm volatile("" : "+v"(tid)); lane = tid & 63; wave = __builtin_amdgcn_readfirstlane(tid >> 6); } while (0)
    unsigned char* ws = a.ws;
    if (threadIdx.x < 2) ((volatile LAS unsigned*)(lds + LDS_BYTES - 16))[threadIdx.x] = 0u;
    __syncthreads();
    if (a.ph_hi == 0x7fffffff) grid.sync();
    const XcdBarrier bar = xcd_barrier_post((unsigned*)(ws + 806912), (volatile LAS unsigned*)(lds + LDS_BYTES - 16));
#ifdef TPROBE
    unsigned long long* tsb = (unsigned long long*)(ws + 802816);
#define STAMP(k) do { if (blockIdx.x == 0 && threadIdx.x == 0) tsb[k] = __builtin_amdgcn_s_memrealtime(); } while (0)
#else
#define STAMP(k) do { } while (0)
#endif
    STAMP(0);
    if (RUN(0)) { for (int rep = 0; rep < ((DUPMASK & 1) ? 2 : 1); ++rep) phase_p0(a, lds, tid, lane, wave, G); }
    { constexpr int l = 0;
        const int pb = 1 + 6 * l;
        const float* xin = l == 0 ? a.in[0] : a.out;
        SEAM(pb); FRESH(); STAMP(1 + 8 * l);
        if (RUN(pb)) { for (int rep = 0; rep < ((DUPMASK & 4) ? 2 : 1); ++rep) phase_h(a, lds, l, xin, tid, lane, wave, G); }
        SEAM(pb + 1); FRESH(); STAMP(2 + 8 * l);
        if (RUN(pb + 1)) { for (int rep = 0; rep < ((DUPMASK & 8) ? 2 : 1); ++rep) { pg8::Gemm g{(const bf16_t*)(ws + WS_H), (const bf16_t*)(ws + WS_WIN) + (size_t)l * NPC * DM, MROWS, NPC, DM}; pg8::StaticOrder S; S.init(MROWS, NPC, G, (int)blockIdx.x);
            pg8::EpiBf16 E{(bf16_t*)(ws + WS_P), NPC}; pg8::gemm_phase<pg8::EpiBf16, pg8::StaticOrder, true, true>(lds, g, S, E); } }
        SEAM(pb + 2); FRESH(); STAMP(3 + 8 * l);
        if (RUN(pb + 2)) {
            for (int rep = 0; rep < ((DUPMASK & 16) ? 2 : 1); ++rep) { u32x4 rc[5], rp[5]; r1_load(a, l, blockIdx.x, tid, rc, rp); for (int u = blockIdx.x; u < 2048; u += G) r1_unit(a, lds, l, u, u + G < 2048 ? u + G : -1, tid, lane, wave, rc, rp); }
        }
        SEAM(pb + 3); FRESH(); STAMP(5 + 8 * l);
        if (RUN(pb + 3)) { for (int rep = 0; rep < ((DUPMASK & 64) ? 2 : 1); ++rep) { if (blockIdx.x < 64) { phase_r2(a, lds, tid, lane, wave); { const int task = 3584 + blockIdx.x * 8 + wave; sb_task(a, lds + wave * 4608, l, task, lane); } }
            else { const int gw = (blockIdx.x - 64) * 8 + wave, NGW = (G - 64) * 8; for (int task = gw; task < 3584; task += NGW) sb_task(a, lds + wave * 4608, l, task, lane); } } }
        SEAM(pb + 4); FRESH(); STAMP(6 + 8 * l);
        if (RUN(pb + 4)) { for (int rep = 0; rep < ((DUPMASK & 128) ? 2 : 1); ++rep) { const int gw = blockIdx.x * 8 + wave, NGW = G * 8; for (int task = gw; task < 8192; task += NGW) r3_task(a, l, task, lane); } }
        SEAM(pb + 5); FRESH(); STAMP(7 + 8 * l);
        if (RUN(pb + 5)) { for (int rep = 0; rep < ((DUPMASK & 256) ? 2 : 1); ++rep) { pg8::Gemm g{(const bf16_t*)(ws + WS_H), (const bf16_t*)(ws + WS_WOUT) + (size_t)l * DM * DM, MROWS, DM, DM}; pg8::StaticOrder S; S.init(MROWS, DM, G, (int)blockIdx.x);
            pg8::EpiRes E{xin, a.out, (const float*)(ws + WS_GATE) + l * 2048}; pg8::gemm_phase<pg8::EpiRes, pg8::StaticOrder, true, true>(lds, g, S, E); } }
        }
    { constexpr int l = 1;
        const int pb = 1 + 6 * l;
        const float* xin = l == 0 ? a.in[0] : a.out;
        SEAM(pb); FRESH(); STAMP(1 + 8 * l);
        if (RUN(pb)) { if (PHMASK & 4) phase_h(a, lds, l, xin, tid, lane, wave, G); }
        SEAM(pb + 1); FRESH(); STAMP(2 + 8 * l);
        if (RUN(pb + 1)) { if (PHMASK & 8) { pg8::Gemm g{(const bf16_t*)(ws + WS_H), (const bf16_t*)(ws + WS_WIN) + (size_t)l * NPC * DM, MROWS, NPC, DM}; pg8::StaticOrder S; S.init(MROWS, NPC, G, (int)blockIdx.x);
            pg8::EpiBf16 E{(bf16_t*)(ws + WS_P), NPC}; pg8::gemm_phase<pg8::EpiBf16, pg8::StaticOrder, true, true>(lds, g, S, E); } }
        SEAM(pb + 2); FRESH(); STAMP(3 + 8 * l);
        if (RUN(pb + 2)) {
            if (PHMASK & 16) { u32x4 rc[5], rp[5]; r1_load(a, l, blockIdx.x, tid, rc, rp); for (int u = blockIdx.x; u < 2048; u += G) r1_unit(a, lds, l, u, u + G < 2048 ? u + G : -1, tid, lane, wave, rc, rp); }
        }
        SEAM(pb + 3); FRESH(); STAMP(5 + 8 * l);
        if (RUN(pb + 3)) { if (PHMASK & 64) { if (blockIdx.x < 64) { phase_r2(a, lds, tid, lane, wave); { const int task = 3584 + blockIdx.x * 8 + wave; sb_task(a, lds + wave * 4608, l, task, lane); } }
            else { const int gw = (blockIdx.x - 64) * 8 + wave, NGW = (G - 64) * 8; for (int task = gw; task < 3584; task += NGW) sb_task(a, lds + wave * 4608, l, task, lane); } } }
        SEAM(pb + 4); FRESH(); STAMP(6 + 8 * l);
        if (RUN(pb + 4)) { if (PHMASK & 128) { const int gw = blockIdx.x * 8 + wave, NGW = G * 8; for (int task = gw; task < 8192; task += NGW) r3_task(a, l, task, lane); } }
        SEAM(pb + 5); FRESH(); STAMP(7 + 8 * l);
        if (RUN(pb + 5)) { if (PHMASK & 256) { pg8::Gemm g{(const bf16_t*)(ws + WS_H), (const bf16_t*)(ws + WS_WOUT) + (size_t)l * DM * DM, MROWS, DM, DM}; pg8::StaticOrder S; S.init(MROWS, DM, G, (int)blockIdx.x);
            pg8::EpiRes E{xin, a.out, (const float*)(ws + WS_GATE) + l * 2048}; pg8::gemm_phase<pg8::EpiRes, pg8::StaticOrder, true, true>(lds, g, S, E); } }
        }
    SEAM(13); FRESH(); STAMP(17);
    if (RUN(13)) { if (PHMASK & 2) phase_final(a, lane, wave, G); }
#ifdef TPROBE
    STAMP(18); grid.sync();
    { float A_ = (float)(tsb[TP_A1] - tsb[TP_A0]) * 0.01f, B_ = (float)(tsb[TP_B1] - tsb[TP_B0]) * 0.01f;
      A_ = __expf(0.13976f * floorf(__logf(fmaxf(A_, 1.f)) / 0.13976f + 0.5f)); B_ = __expf(0.13976f * floorf(__logf(fmaxf(B_, 1.f)) / 0.13976f + 0.5f));
      for (int i = blockIdx.x * 512 + threadIdx.x; i < (1 << 20); i += G * 512) a.out[i] = i == 0 ? A_ * 1000.f : B_; }
#endif
}

#ifdef DBG_CHECK
#define ACC(k, got, want) do { const float g_ = (got), w_ = (want); const float d_ = g_ - w_; nm[k] += (d_ == d_) ? fminf(d_ * d_, 1e30f) : 1e30f; dn[k] += w_ * w_; } while (0)
__device__ __forceinline__ unsigned hsh(unsigned x) { x ^= x >> 16; x *= 0x7feb352du; x ^= x >> 15; x *= 0x846ca68bu; x ^= x >> 16; return x; }
__device__ __forceinline__ float dbg_silu(float x) { return x / (1.f + __expf(-x)); }
__device__ __forceinline__ float dbg_mod(const Args& a, int l, int b, int n) { float s = a.in[4][l * 3072 + n]; for (int k = 0; k < 1024; ++k) s += dbg_silu(a.in[1][b * 1024 + k]) * a.in[3][((size_t)l * 1024 + k) * 3072 + n]; return s; }
#define sh(col) (bf2f(pr[col]) + ((t > 0 ? bf2f(pr[(col) - NPC]) : 0.f) - bf2f(pr[col])) * mu[col])
#define DQ(Dp, mat, row, el) bf2f(*(const bf16_t*)((Dp) + (mat) * 8192 + (row) * 128 + ((((el) >> 3) ^ (((row) >> 1) & 7)) * 16) + ((el) & 7) * 2))
#define KP(jj) (32 * ((jj) >> 5) + 8 * (((jj) >> 2) & 3) + 4 * (((jj) >> 4) & 1) + ((jj) & 3))
constexpr int T0 = 7992;
__global__ void __launch_bounds__(256) dbg_check(Args a, int stage) {
    __shared__ float red[256]; __shared__ float st[64 * 65]; __shared__ float vec[8][64]; __shared__ float s64[64 * 65];
    float nm[16], dn[16];
#pragma unroll
    for (int i = 0; i < 16; ++i) { nm[i] = 0.f; dn[i] = 0.f; }
    unsigned char* ws = a.ws; float* err = (float*)(ws + WS_DBG); const int tid = threadIdx.x; float e = 0.f;
    const bf16_t* P = (const bf16_t*)(ws + WS_P); const bf16_t* Hb = (const bf16_t*)(ws + WS_H);
    if (stage == 1) {
        if (tid < 32) err[tid] = 0.f; __syncthreads();
        for (int s = tid; s < 4096; s += 256) { const unsigned r = hsh(s * 2654435761u + 17u); const int l = r & 1, n = (r >> 1) % NPC, k = (r >> 14) & 1023;
            const int sn = n < PC_PAD ? n : (n < PC_SQ ? -1 : n - 128); const float want = sn < 0 ? 0.f : bf2f(f2bf(a.in[5][((size_t)l * 1024 + k) * IN_COLS + sn]));
            ACC(1, bf2f(((const bf16_t*)(ws + WS_WIN))[((size_t)l * NPC + n) * 1024 + k]), want);
            const int n2 = n & 1023; ACC(1, bf2f(((const bf16_t*)(ws + WS_WOUT))[((size_t)l * 1024 + n2) * 1024 + k]), bf2f(f2bf(a.in[6][((size_t)l * 1024 + k) * 1024 + n2]))); }
    } else if (stage == 2) {
        for (int s = tid; s < 256; s += 256) { const unsigned r = hsh(s + 99u); const int m = r % MROWS, k = (r >> 15) & 1023, b = m >> 13;
            float ss = 0.f; for (int j = 0; j < 1024; ++j) { const float x = a.in[0][(size_t)m * 1024 + j]; ss += x * x; }
            const float rstd = 1.f / sqrtf(ss / 1024.f + 1e-6f); const float want = a.in[0][(size_t)m * 1024 + k] * rstd * a.in[2][k] * (1.f + dbg_mod(a, 0, b, 1024 + k)) + dbg_mod(a, 0, b, k);
            ACC(2, bf2f(Hb[(size_t)m * 1024 + k]), want);
            ACC(2, ((const float*)(ws + WS_GATE))[b * 1024 + k], dbg_mod(a, 0, b, 2048 + k)); }
    } else if (stage == 3) {
        for (int s = tid; s < 2048; s += 256) { const unsigned r = hsh(s + 777u); const int m = r % MROWS, n = (r >> 15) % NPC; float acc = 0.f;
            for (int k = 0; k < 1024; ++k) acc += bf2f(Hb[(size_t)m * 1024 + k]) * bf2f(((const bf16_t*)(ws + WS_WIN))[(size_t)n * 1024 + k]);
            ACC(3, bf2f(P[(size_t)m * NPC + n]), acc); }
    } else if (stage == 4) {
        const unsigned r = hsh(tid + 4242u); const int b = r & 1, h = (r >> 1) & 7; int t = (r >> 4) & 8191; if (tid < 40) t = tid;
        const bf16_t* qp = P + (size_t)(b * SEQ + t) * NPC + PC_SQ + h * 64; float* o = st + (tid & 63) * 65; for (int d = 0; d < 64; ++d) o[d] = 0.f; float after = 0.f; if (tid < 64) {
        for (int s = t - 1; s >= 0 && after > -110.f; --s) { const bf16_t* kp = P + (size_t)(b * SEQ + s) * NPC + PC_SK + h * 64; float z = 0.f; for (int d = 0; d < 64; ++d) z += bf2f(qp[d]) * bf2f(kp[d]); z *= 0.125f;
            const float sp = fmaxf(z, 0.f) + __logf(1.f + __expf(-fabsf(z))); const float w = __expf(z - sp + after); const bf16_t* vp = P + (size_t)(b * SEQ + s) * NPC + PC_SV + h * 64;
            for (int d = 0; d < 64; ++d) o[d] += w * bf2f(vp[d]); after -= sp; }
        float ss = 0.f; for (int d = 0; d < 64; ++d) ss += o[d] * o[d]; const float rms = 1.f / sqrtf(ss / 64.f + 1e-6f);
        for (int d = 0; d < 64; ++d) { const float g = bf2f(P[(size_t)(b * SEQ + t) * NPC + PC_SG + h * 64 + d]); const float want = o[d] * rms * a.in[17][h * 64 + d] * dbg_silu(g);
            ACC(4, bf2f(Hb[(size_t)(b * SEQ + t) * 1024 + 512 + h * 64 + d]), want); } }
    } else if (stage == 5 || stage == 6) {
        if (tid < 64) { const int b = stage == 5 ? 0 : 1, h = stage == 5 ? 0 : 5, j = tid, jg = h * 64 + j; const float* mu = a.in[7];
            for (int x = 0; x < 64; ++x) st[tid * 65 + x] = 0.f;
            float pd = 1.f;
            float* expy = (float*)(ws + WS_DBG + 4096) + (stage - 5) * 200 * 64;
            for (int t = 0; t < T0 + 200; ++t) { const bf16_t* pr = P + (size_t)(b * SEQ + t) * NPC;
                const float rr = sh(PC_R + jg), kr = sh(PC_K + jg), vv = sh(PC_V + jg); float wa = a.in[8][jg], aa = a.in[10][jg];
                for (int m = 0; m < 64; ++m) { wa += tanh_f(sh(PC_ZW + m)) * a.in[9][(size_t)m * 512 + jg]; aa += sh(PC_ZA + m) * a.in[11][(size_t)m * 512 + jg]; }
                const float sp = fmaxf(-wa, 0.f) + __logf(1.f + __expf(-fabsf(wa))); const float dec = __expf(-__expf(-sp - 0.5f)); const float av = 1.f / (1.f + __expf(-aa));
                float kk = kr * a.in[12][jg]; vec[6][j] = kk * kk; __syncthreads(); float n2 = 0.f; for (int x = 0; x < 64; ++x) n2 += vec[6][x]; kk *= 1.f / sqrtf(fmaxf(n2, 1e-24f));
                const float kp = kr * (1.f + (av - 1.f) * a.in[13][jg]);
                vec[0][j] = rr; vec[1][j] = dec; vec[2][j] = kp; vec[3][j] = vv; vec[4][j] = kk; vec[5][j] = kk * av; vec[7][j] = rr * kp * a.in[14][jg]; __syncthreads();
                float sa = 0.f; for (int x = 0; x < 64; ++x) sa += st[tid * 65 + x] * -vec[4][x];
                float y = 0.f; for (int x = 0; x < 64; ++x) { float s2 = st[tid * 65 + x] * vec[1][x] + sa * vec[5][x] + vec[3][tid] * vec[2][x]; st[tid * 65 + x] = s2; y += s2 * vec[0][x]; }
                float bon = 0.f; for (int x = 0; x < 64; ++x) bon += vec[7][x];
                __syncthreads(); vec[6][j] = y; __syncthreads(); float mean = 0.f; for (int x = 0; x < 64; ++x) mean += vec[6][x]; mean /= 64.f; float var = 0.f; for (int x = 0; x < 64; ++x) var += (vec[6][x] - mean) * (vec[6][x] - mean); var /= 64.f;
                const float yn = (y - mean) / sqrtf(var + 64e-5f) * a.in[15][jg] + a.in[16][jg] + bon * vv; const float g = bf2f(pr[PC_G + jg]);
                if (t >= T0) expy[(t - T0) * 64 + j] = y; if (t >= T0) expy[2 * 200 * 64 + (t - T0) * 64 + j] = yn * dbg_silu(g);
                { const int u0 = (b * 8 + h) * 128; const unsigned char* D0 = ws + WS_D + (size_t)u0 * 32768; const unsigned char* D1 = D0 + 32768; const int i = tid;
                  pd *= dec;
                  if (t < 64) ACC(11, DQ(D0, 3, i, t), y);
                  if (t == 63) { for (int x = 0; x < 64; ++x) { ACC(10, DQ(D0, 2, i, x), st[i * 65 + x]); s64[i * 65 + x] = st[i * 65 + x]; }
                      ACC(12, ((const float*)(ws + WS_GAM))[(size_t)u0 * 64 + j], pd); }
                  if (t >= 64 && t < 128) { float yp = DQ(D1, 3, i, t - 64); for (int x = 0; x < 64; ++x) yp += DQ(D1, 1, t - 64, KP(x)) * s64[i * 65 + x]; ACC(15, yp, y); }
                  if (t == 127) { for (int jp = 0; jp < 64; ++jp) { float sp2 = ((const float*)(ws + WS_GAM))[(size_t)(u0 + 1) * 64 + jp] * s64[i * 65 + jp] + DQ(D1, 2, i, jp);
                          for (int x = 0; x < 64; ++x) sp2 += DQ(D1, 0, jp, KP(x)) * s64[i * 65 + x]; ACC(14, sp2, st[i * 65 + jp]); } }
                }
                __syncthreads(); }
            }
    } else if (stage == 7 || stage == 8) {
        const float* expy = (const float*)(ws + WS_DBG + 4096);
        for (int which = 0; which < 2; ++which) { const int b = which ? 1 : 0, h = which ? 5 : 0;
            for (int s = tid; s < 200 * 64; s += 256) { const int t = s >> 6, j = s & 63;
                if (stage == 7) { const float gv = *(const float*)((const unsigned char*)P + (size_t)(b * SEQ + T0 + t) * NPC * 2 + (h * 64 + j) * 4); if (t < 64) ACC(7, gv, expy[which * 200 * 64 + s]); else ACC(13, gv, expy[which * 200 * 64 + s]); }
                else ACC(8, bf2f(Hb[(size_t)(b * SEQ + T0 + t) * 1024 + h * 64 + j]), expy[2 * 200 * 64 + which * 200 * 64 + s]); } }
    } else if (stage == 9) {
        for (int s = tid; s < 1024; s += 256) { const unsigned r = hsh(s + 31337u); const int m = r % MROWS, n = (r >> 15) & 1023, b = m >> 13; float acc = 0.f;
            for (int k = 0; k < 1024; ++k) acc += bf2f(Hb[(size_t)m * 1024 + k]) * bf2f(((const bf16_t*)(ws + WS_WOUT))[(size_t)n * 1024 + k]);
            ACC(9, a.out[(size_t)m * 1024 + n], a.in[0][(size_t)m * 1024 + n] + ((const float*)(ws + WS_GATE))[b * 1024 + n] * acc); }
    } else if (stage == 20) {
        const unsigned char* dump = ws + WS_DUMP; float* REF = (float*)(ws + WS_DUMP + 156672);
        float* Rr = REF, *Rc = REF + 4096, *Rkp = REF + 8192, *Rv = REF + 12288, *Rkk = REF + 16384, *Ra = REF + 20480;
        { const int t = tid >> 2, jq = tid & 3; const bf16_t* pr = P + (size_t)t * NPC; const float* mu = a.in[7]; float n2 = 0.f;
          for (int jj = 0; jj < 16; ++jj) { const int j = jq * 16 + jj; const float kr = sh(PC_K + j); const float kk = kr * a.in[12][j]; n2 += kk * kk; }
          n2 += __shfl_xor(n2, 1); n2 += __shfl_xor(n2, 2); const float rn = 1.f / sqrtf(fmaxf(n2, 1e-24f));
          for (int jj = 0; jj < 16; ++jj) { const int j = jq * 16 + jj; const float rr = sh(PC_R + j), kr = sh(PC_K + j), vv = sh(PC_V + j); float wa = a.in[8][j], aa = a.in[10][j];
              for (int m = 0; m < 64; ++m) { wa += tanh_f(sh(PC_ZW + m)) * a.in[9][(size_t)m * 512 + j]; aa += sh(PC_ZA + m) * a.in[11][(size_t)m * 512 + j]; }
              const float sp = fmaxf(-wa, 0.f) + __logf(1.f + __expf(-fabsf(wa))); const float av = 1.f / (1.f + __expf(-aa));
              Rr[t * 64 + j] = rr; Rc[t * 64 + j] = -__expf(-sp - 0.5f); Rkp[t * 64 + j] = kr * (1.f + (av - 1.f) * a.in[13][j]); Rv[t * 64 + j] = vv; Rkk[t * 64 + j] = kr * a.in[12][j] * rn; Ra[t * 64 + j] = av; } }
        __threadfence(); __syncthreads();
        if (tid < 64) { float c = 0.f; for (int t = 0; t < 64; ++t) { c += Rc[t * 64 + tid]; Rc[t * 64 + tid] = c; } }
        __threadfence(); __syncthreads();
#define DM_(off, row, col) bf2f(*(const bf16_t*)(dump + (off) + (row) * 144 + (col) * 2))
        for (int s = tid; s < 4096; s += 256) { const int t = s >> 6, j = s & 63; const float ci = Rc[s], ce = t ? Rc[s - 64] : 0.f, ct = Rc[63 * 64 + j], kk = Rkk[s], av = Ra[s], kp = Rkp[s];
            const float Ag = -kk * __expf(ce), Rg = Rr[s] * __expf(ci), Bg = kk * av * __expf(-ci), Kg = kp * __expf(-ci);
            ACC(1, DM_(0, t, j), Ag); ACC(2, DM_(9216, t, j), Rg); ACC(3, DM_(18432, t, j), Bg); ACC(4, DM_(27648, t, j), Kg);
            ACC(5, DM_(36864, j, t), Ag); ACC(6, DM_(46080, j, t), kk * av * __expf(ct - ci)); ACC(6, DM_(55296, j, t), kp * __expf(ct - ci)); ACC(7, DM_(64512, j, t), Rv[s]); }
        for (int s = tid; s < 4096; s += 256) { const int t = s >> 6, u_ = s & 63; float ab = 0.f, ak = 0.f, rb = 0.f, rk = 0.f;
            for (int j = 0; j < 64; ++j) { const float ag = DM_(0, t, j), rg = DM_(9216, t, j), bg = DM_(18432, u_, j), kg = DM_(27648, u_, j); ab += ag * bg; ak += ag * kg; rb += rg * bg; rk += rg * kg; }
            if (!(u_ < t)) { ab = 0.f; ak = 0.f; } if (!(u_ <= t)) { rb = 0.f; rk = 0.f; }
            ACC(8, DM_(73728, t, u_), ab); ACC(8, DM_(73728 + 9216, u_, t), ab); ACC(9, DM_(92160, t, u_), ak); ACC(9, DM_(92160 + 9216, t, u_), rb); ACC(9, DM_(92160 + 18432, t, u_), rk); }
        if (tid < 64) { for (int t = 0; t < 64; ++t) { float v = (t == tid) ? 1.f : 0.f; for (int k = 0; k < t; ++k) v += DM_(73728, t, k) * st[k * 65 + tid]; st[t * 65 + tid] = v; } }
        __syncthreads();
        for (int s = tid; s < 4096; s += 256) { const int t = s >> 6, u_ = s & 63; ACC(10, DM_(119808, t, u_), st[t * 65 + u_]);
            float akv = 0.f; for (int k = 0; k < 64; ++k) akv += DM_(92160, u_, k) * DM_(64512, t, k);
            ACC(11, DM_(129024, t, u_), akv); ACC(14, DM_(-49152, t, u_), akv); }
        for (int s = tid; s < 8192; s += 256) { const int n = s >> 6, t = s & 63; float x = 0.f; for (int k = 0; k < 64; ++k) x += DM_(119808, t, k) * (n < 64 ? DM_(36864, n, k) : DM_(129024, n - 64, k));
            ACC(12, DM_(138240, n, t), x); }
        { const unsigned char* D0 = ws + WS_D;
          for (int s = tid; s < 4096; s += 256) { const int r_ = s >> 6, c_ = s & 63; float pp = 0.f, y0 = 0.f;
              for (int k = 0; k < 64; ++k) { pp += DM_(46080, r_, k) * DM_(138240, c_, k); y0 += DM_(92160 + 9216, c_, k) * DM_(138240, 64 + r_, k) + DM_(92160 + 18432, c_, k) * DM_(64512, r_, k); }
              ACC(13, DQ(D0, 0, r_, KP(c_)), pp); ACC(13, DQ(D0, 3, r_, c_), y0); } }
    } else if (stage == 30) {
        for (int s = tid; s < 256; s += 256) { const unsigned r = hsh(s + 555u); const int m = r % MROWS, k = (r >> 15) & 1023, b = m >> 13;
            float ss = 0.f; for (int j = 0; j < 1024; ++j) { const float x = a.out[(size_t)m * 1024 + j]; ss += x * x; }
            const float rstd = 1.f / sqrtf(ss / 1024.f + 1e-6f); const float want = a.out[(size_t)m * 1024 + k] * rstd * a.in[2][1024 + k] * (1.f + dbg_mod(a, 1, b, 1024 + k)) + dbg_mod(a, 1, b, k);
            ACC(5, bf2f(Hb[(size_t)m * 1024 + k]), want);
            ACC(5, ((const float*)(ws + WS_GATE))[2048 + b * 1024 + k], dbg_mod(a, 1, b, 2048 + k)); }
    } else if (stage == 31) {
        for (int s = tid; s < 256; s += 256) { const unsigned r = hsh(s + 888u); const int m = r % MROWS; float ss = 0.f;
            for (int j = 0; j < 1024; ++j) { const float x = a.out[(size_t)m * 1024 + j] / a.in[18][j]; ss += x * x; } ACC(6, ss / 1024.f, 1.f); }
    } else if (stage == 99) {
        for (int i = tid; i < MROWS * DM; i += 256) a.out[i] = 0.f;
        __syncthreads();
        if (tid == 0) { for (int k = 1; k <= 14; ++k) if (!(err[16 + k] < 0.03f)) { a.out[0] = (float)(10 + k) * 1e6f; return; } }
        if (tid == 0) { const float th[9] = {0.003f, 0.005f, 0.01f, 0.02f, 0.03f, 0.05f, 0.1f, 0.3f, 1.0f}; int c8 = 9, c13 = 9, c5 = 9, c6 = 9;
            for (int i = 8; i >= 0; --i) { if (err[8] < th[i]) c8 = i; if (err[13] < th[i]) c13 = i; if (err[5] < th[i]) c5 = i; if (err[6] < th[i]) c6 = i; }
            float pw = 1e6f; for (int z = 0; z < c5 + (c6 > 4 ? 10 : 0); ++z) pw *= 10.f; a.out[0] = (float)(10 * (1 + (c8 > 8 ? 8 : c8)) + c13) * pw; return; }
        if (tid == 0) { const int lo[6] = {7, 13, 10, 11, 12, 14}; const int hi[4] = {15, 8, 9, 0}; int lb = 0, hb = 0;
            for (int i = 0; i < 6; ++i) if (!(err[lo[i]] < 0.03f)) lb |= 1 << i;
            for (int i = 0; i < 3; ++i) if (!(err[hi[i]] < 0.03f)) hb |= 1 << i;
            if (!(err[1] < 0.03f) || !(err[2] < 0.03f) || !(err[3] < 0.03f) || !(err[4] < 0.03f)) hb |= 8;
            if (lb | hb) { float pw = 1e4f; for (int z = 0; z < hb; ++z) pw *= 10.f; a.out[0] = (float)(10 + lb) * pw; } }
        return;
    }
    __syncthreads();
#pragma unroll
    for (int k = 1; k < 16; ++k) { if (stage == 6 && k >= 10) continue; if ((stage == 5 || stage == 6) && k < 10) continue; red[tid] = nm[k]; __syncthreads(); float n_ = 0.f; if (tid == 0) for (int i = 0; i < 256; ++i) n_ += red[i]; __syncthreads(); red[tid] = dn[k]; __syncthreads();
        if (tid == 0) { float d_ = 0.f; for (int i = 0; i < 256; ++i) d_ += red[i]; if (n_ > 0.f || d_ > 0.f) err[(stage == 20 ? 16 : 0) + k] = sqrtf(n_ / (d_ + 1e-30f)); } __syncthreads(); }
}
#endif
extern "C" void kernel_launch(void* const* d_in, const int* in_sizes, int n_in, void* d_out, int out_size, void* d_ws, size_t ws_size, hipStream_t stream) {
    static int grid = 0;
    if (grid == 0) {
        if (n_in != 19 || out_size != MROWS * DM || ws_size < WS_END) { fprintf(stderr, "kernel_launch: unexpected shapes (n_in %d, out %d, ws %zu)\n", n_in, out_size, ws_size); grid = -1; return; }
        int dev = 0, cus = 0, per_cu = 0;
        (void)hipGetDevice(&dev); (void)hipDeviceGetAttribute(&cus, hipDeviceAttributeMultiprocessorCount, dev);
        if (hipFuncSetAttribute((const void*)fwd_kernel, hipFuncAttributeMaxDynamicSharedMemorySize, LDS_BYTES) != hipSuccess) { fprintf(stderr, "kernel_launch: hipFuncSetAttribute failed\n"); grid = -1; return; }
        if (hipOccupancyMaxActiveBlocksPerMultiprocessor(&per_cu, (const void*)fwd_kernel, 512, LDS_BYTES) != hipSuccess || per_cu < 1) { fprintf(stderr, "kernel_launch: occupancy query says %d\n", per_cu); per_cu = 1; }
        (void)hipGetLastError();
        grid = cus * 1;
        if (grid < 16) { grid = -1; return; }
    }
    if (grid < 0) return;
    Args a{};
    for (int i = 0; i < 19; ++i) a.in[i] = (const float*)d_in[i];
    a.out = (float*)d_out; a.ws = (unsigned char*)d_ws;
#if MK_PER_PHASE
    for (int ph = 0; ph < NPHASE; ++ph) { a.ph_lo = ph; a.ph_hi = ph + 1; hipLaunchKernelGGL(fwd_kernel, dim3(grid), dim3(512), LDS_BYTES, stream, a);
#ifdef DBG_CHECK
        if (ph == 0) hipLaunchKernelGGL(dbg_check, dim3(1), dim3(256), 0, stream, a, 1);
        if (ph == 1) hipLaunchKernelGGL(dbg_check, dim3(1), dim3(256), 0, stream, a, 2);
        if (ph == 2) hipLaunchKernelGGL(dbg_check, dim3(1), dim3(256), 0, stream, a, 3);
        if (ph == 3) { hipLaunchKernelGGL(dbg_check, dim3(1), dim3(256), 0, stream, a, 20); hipLaunchKernelGGL(dbg_check, dim3(1), dim3(256), 0, stream, a, 4); hipLaunchKernelGGL(dbg_check, dim3(1), dim3(256), 0, stream, a, 5); hipLaunchKernelGGL(dbg_check, dim3(1), dim3(256), 0, stream, a, 6); }
        if (ph == 4) hipLaunchKernelGGL(dbg_check, dim3(1), dim3(256), 0, stream, a, 7);
        if (ph == 5) hipLaunchKernelGGL(dbg_check, dim3(1), dim3(256), 0, stream, a, 8);
        if (ph == 6) hipLaunchKernelGGL(dbg_check, dim3(1), dim3(256), 0, stream, a, 9);
        if (ph == 7) hipLaunchKernelGGL(dbg_check, dim3(1), dim3(256), 0, stream, a, 30);
        if (ph == NPHASE - 1) { hipLaunchKernelGGL(dbg_check, dim3(1), dim3(256), 0, stream, a, 31); hipLaunchKernelGGL(dbg_check, dim3(1), dim3(256), 0, stream, a, 99); }
#endif
    }
#else
    a.ph_lo = 0; a.ph_hi = NPHASE;
    (void)hipMemsetAsync((unsigned char*)d_ws + 806912, 0, 16384, stream);
    void* args[] = {&a};
    hipError_t e = hipLaunchCooperativeKernel((const void*)fwd_kernel, dim3(grid), dim3(512), args, LDS_BYTES, stream);
    if (e != hipSuccess) fprintf(stderr, "cooperative launch failed: %s (grid %d)\n", hipGetErrorString(e), grid);
#endif
}
```

```cpp
#include <hip/hip_runtime.h>
#include <hip/hip_cooperative_groups.h>
#include <cstdio>
#include <cstdint>
namespace cg = cooperative_groups;
namespace pg8 {
#define PG8_LAS __attribute__((address_space(3)))
typedef unsigned short bf16_t;
typedef short bf16x8 __attribute__((ext_vector_type(8)));
typedef float f32x4 __attribute__((ext_vector_type(4)));
typedef unsigned u32x4 __attribute__((ext_vector_type(4)));
constexpr int BM = 256, BK = 64, HALF = 128, HTB = HALF * BK * 2  , STAGE_BYTES = 8 * HTB, NXCD = 8, WGM = 8;

__host__ __device__ __forceinline__ int lds_byte(int r, int c) { const int st = (r >> 4) * 2 + (c >> 5), rr = r & 15, cc = c & 31, ob = rr * 64 + cc * 2; return st * 1024 + (ob ^ (((ob >> 9) & 1) << 5)); }
__host__ __device__ __forceinline__ void stage_rc(int b, int& R, int& C) { const int st = b / 1024, sb = b % 1024, swz = sb ^ (((sb >> 9) & 1) << 5); R = (st >> 1) * 16 + swz / 64; C = (st & 1) * 32 + (swz % 64) / 2; }
__host__ __device__ __forceinline__ int perm32(int rho) { const int n = rho >> 4, i = rho & 15; return 8 * (i >> 2) + 4 * n + (i & 3); }

struct Unit { int pm, pn; };
struct Gemm { const bf16_t* A; const bf16_t* Bt; int M, N, K; };

struct StaticOrder {
    int nM, nN, nwg, G, c;
    __host__ __device__ void init(int M, int N, int G_, int c_) { nM = M / BM; nN = N / BM; nwg = nM * nN; G = G_; c = c_; }
    __host__ __device__ bool next(int i, Unit& u) const {
        const long L = (long)i * G + c; if (L >= nwg) return false;
        int wgid = (int)L; { const int q = nwg / NXCD, r = nwg % NXCD, xcd = wgid % NXCD, off = wgid / NXCD; wgid = (xcd < r ? xcd * (q + 1) : r * (q + 1) + (xcd - r) * q) + off; }
        const int nig = WGM * nN, gid = wgid / nig, fm = gid * WGM, gsz = (nM - fm) < WGM ? (nM - fm) : WGM;
        u.pm = fm + ((wgid % nig) % gsz); u.pn = (wgid % nig) / gsz; return true;
    }
    __device__ __forceinline__ void a_ready(const Unit&) const {}
    __device__ __forceinline__ void done(const Unit&) const {}
};

typedef __bf16 bf16v2_t __attribute__((ext_vector_type(2)));
typedef float f32v2_t __attribute__((ext_vector_type(2)));
__device__ __forceinline__ unsigned cvt_pk_bf16(float lo, float hi) { f32v2_t v = {lo, hi}; bf16v2_t b = __builtin_convertvector(v, bf16v2_t); return __builtin_bit_cast(unsigned, b); }
struct EpiBf16 {
    static constexpr bool PERM = true, AFTER_DRAIN = false;
    bf16_t* O; int ldc;
    __device__ __forceinline__ void operator()(const f32x4 (&acc)[2][2][4][2], const Unit& u, int wr, int wc, int fr, int fq) const {
        const int row0 = u.pm * BM + wr * 64 + fr; const int col0 = u.pn * BM + wc * 32 + 8 * fq;
#pragma unroll
        for (int ai = 0; ai < 2; ++ai)
#pragma unroll
            for (int m = 0; m < 4; ++m) { bf16_t* rowp = O + (size_t)(row0 + ai * HALF + m * 16) * ldc + col0;
#pragma unroll
                for (int bj = 0; bj < 2; ++bj) { const f32x4 v0 = acc[ai][bj][m][0], v1 = acc[ai][bj][m][1];
                    u32x4 w; w.x = cvt_pk_bf16(v0[0], v0[1]); w.y = cvt_pk_bf16(v0[2], v0[3]); w.z = cvt_pk_bf16(v1[0], v1[1]); w.w = cvt_pk_bf16(v1[2], v1[3]);
                    *(u32x4*)(rowp + bj * HALF) = w; } }
    }
    __device__ __forceinline__ void fused(f32x4 (&)[2][2][4][2], const Unit&, int, int, int, int, PG8_LAS unsigned char*, int, int) const {}
};
struct EpiRes {
    static constexpr bool PERM = false, AFTER_DRAIN = false;
    const float* xin; float* out; const float* gate;
    __device__ __forceinline__ void operator()(const f32x4 (&acc)[2][2][4][2], const Unit& u, int wr, int wc, int fr, int fq) const {
        const int row0 = u.pm * BM + wr * 64 + fr; const int col0 = u.pn * BM + wc * 32 + 4 * fq; const float* gp = gate + ((u.pm * BM) >> 13) * 1024;
        f32x4 gv[2][2];
#pragma unroll
        for (int bj = 0; bj < 2; ++bj)
#pragma unroll
            for (int n = 0; n < 2; ++n) gv[bj][n] = *(const f32x4*)(gp + col0 + bj * HALF + n * 16);
#pragma unroll
        for (int ai = 0; ai < 2; ++ai)
#pragma unroll
            for (int m = 0; m < 4; ++m) { const size_t off = (size_t)(row0 + ai * HALF + m * 16) * 1024 + col0;
#pragma unroll
                for (int bj = 0; bj < 2; ++bj)
#pragma unroll
                    for (int n = 0; n < 2; ++n) { const f32x4 xv = *(const f32x4*)(xin + off + bj * HALF + n * 16);
                        *(f32x4*)(out + off + bj * HALF + n * 16) = xv + gv[bj][n] * acc[ai][bj][m][n]; } }
    }
    __device__ __forceinline__ void fused(f32x4 (&)[2][2][4][2], const Unit&, int, int, int, int, PG8_LAS unsigned char*, int, int) const {}
};
template <class Epi, class Sched, bool ALIGN_EPI = false, bool SP2 = false>
__device__ __forceinline__ void gemm_phase(PG8_LAS unsigned char* lds, const Gemm g, const Sched& S, const Epi& E) {
    const int tid = threadIdx.x, wid = __builtin_amdgcn_readfirstlane(tid >> 6), lane = tid & 63, wr = wid >> 2, wc = wid & 3, fr = lane & 15, fq = lane >> 4;
    const int K = g.K, nt = K / BK;
    unsigned voffA[2], voffB[2];
#pragma unroll
    for (int i = 0; i < 2; ++i) { int R, C; stage_rc(tid * 16 + i * 8192, R, C); const int Rb = Epi::PERM ? ((R & ~31) + perm32(R & 31)) : R;
        voffA[i] = (unsigned)(R * K + C) * 2u; voffB[i] = (unsigned)(Rb * K + C) * 2u; }
    const size_t kstep = (size_t)(BK * 2);
    const size_t hstep = (size_t)HALF * K * 2;
    const size_t tstep = 2 * hstep;
    const unsigned ldsw = (unsigned)wid * 1024u;
    const int aoff = lds_byte(wr * 64 + fr, fq * 8), boff = lds_byte(wc * 32 + fr, fq * 8);
#define PG8_SA(b, h) (((b) * 2 + (h)) * HTB)
#define PG8_SB(b, h) ((4 + (b) * 2 + (h)) * HTB)
#define PG8_STAGE(bufoff, gbase, voff) do { _Pragma("unroll") for (int _i = 0; _i < 2; ++_i) \
        __builtin_amdgcn_global_load_lds((const unsigned*)((const char*)(gbase) + (voff)[_i]), (PG8_LAS unsigned*)(lds + (bufoff) + ldsw + _i * 8192), 16, 0, 0); } while (0)
#define PG8_LDA(dst, b, h) do { _Pragma("unroll") for (int m = 0; m < 4; ++m) _Pragma("unroll") for (int k = 0; k < 2; ++k) dst[m][k] = *(const PG8_LAS bf16x8*)(lds + PG8_SA(b, h) + aoff + m * 2048 + k * 1024); } while (0)
#define PG8_LDB(dst, b, h) do { _Pragma("unroll") for (int n = 0; n < 2; ++n) _Pragma("unroll") for (int k = 0; k < 2; ++k) dst[n][k] = *(const PG8_LAS bf16x8*)(lds + PG8_SB(b, h) + boff + n * 2048 + k * 1024); } while (0)
#define PG8_MMA(ai, bj, At, Bt) do { __builtin_amdgcn_s_setprio(1); _Pragma("unroll") for (int m = 0; m < 4; ++m) _Pragma("unroll") for (int n = 0; n < 2; ++n) _Pragma("unroll") for (int k = 0; k < 2; ++k) \
        acc[ai][bj][m][n] = __builtin_amdgcn_mfma_f32_16x16x32_bf16(Bt[n][k], At[m][k], acc[ai][bj][m][n], 0, 0, 0); __builtin_amdgcn_s_setprio(0); } while (0)
#define PG8_WAIT_V(n) asm volatile("s_waitcnt vmcnt(" #n ")" ::: "memory")
#define PG8_WAIT_L(n) asm volatile("s_waitcnt lgkmcnt(" #n ")" ::: "memory")
#define PG8_BAR __builtin_amdgcn_s_barrier()
#define PG8_SCHED __builtin_amdgcn_sched_barrier(0)
    Unit cur, nxt; int ui = 0;
    if (!S.next(0, cur)) return;
    f32x4 acc[2][2][4][2];
#pragma unroll
    for (int a = 0; a < 2; ++a)
#pragma unroll
        for (int b = 0; b < 2; ++b)
#pragma unroll
            for (int m = 0; m < 4; ++m)
#pragma unroll
                for (int n = 0; n < 2; ++n) acc[a][b][m][n] = (f32x4){0.f, 0.f, 0.f, 0.f};
    bf16x8 At[4][2], B0[2][2], B1[2][2];
    const char* cA = (const char*)g.A + (size_t)cur.pm * tstep; const char* cB = (const char*)g.Bt + (size_t)cur.pn * tstep;
    S.a_ready(cur);
    if constexpr (SP2) {
        PG8_STAGE(PG8_SB(0, 0), cB, voffB); PG8_STAGE(PG8_SB(0, 1), cB + hstep, voffB); PG8_STAGE(PG8_SA(0, 0), cA, voffA); PG8_STAGE(PG8_SA(0, 1), cA + hstep, voffA);
        if (wr == 1) PG8_BAR;
        PG8_WAIT_V(2); PG8_BAR;
        PG8_STAGE(PG8_SB(1, 0), cB + kstep, voffB); PG8_STAGE(PG8_SA(1, 0), cA + kstep, voffA); PG8_STAGE(PG8_SB(1, 1), cB + hstep + kstep, voffB);
        PG8_WAIT_V(6); PG8_BAR;
    } else {
        PG8_STAGE(PG8_SB(0, 0), cB, voffB); PG8_STAGE(PG8_SA(0, 0), cA, voffA); PG8_STAGE(PG8_SB(0, 1), cB + hstep, voffB); PG8_STAGE(PG8_SA(0, 1), cA + hstep, voffA);
        if (wr == 1) PG8_BAR;
        PG8_WAIT_V(4); PG8_BAR;
        PG8_STAGE(PG8_SB(1, 0), cB + kstep, voffB); PG8_STAGE(PG8_SA(1, 0), cA + kstep, voffA); PG8_STAGE(PG8_SB(1, 1), cB + hstep + kstep, voffB);
        PG8_WAIT_V(6); PG8_BAR;
    }
    for (;;) {
        const bool has_next = S.next(ui + 1, nxt);
        const char* nA = has_next ? (const char*)g.A + (size_t)nxt.pm * tstep : cA; const char* nB = has_next ? (const char*)g.Bt + (size_t)nxt.pn * tstep : cB;
        for (int t = 0; t < nt; t += 2) {
            const bool last = (t == nt - 2);
            const char* a1 = cA + (size_t)(t + 1) * kstep;
            const char* a2 = last ? nA : cA + (size_t)(t + 2) * kstep; const char* b2 = last ? nB : cB + (size_t)(t + 2) * kstep;
            const char* a3 = a2 + kstep; const char* b3 = b2 + kstep;
            if (last && has_next) S.a_ready(nxt);
            if constexpr (SP2) {
            PG8_LDB(B0, 0, 0); PG8_LDB(B1, 0, 1); PG8_SCHED; PG8_LDA(At, 0, 0); PG8_STAGE(PG8_SA(1, 1), a1 + hstep, voffA);
            PG8_WAIT_V(8); PG8_WAIT_L(0); PG8_BAR; PG8_MMA(0, 0, At, B0); PG8_MMA(0, 1, At, B1); PG8_BAR; PG8_SCHED;
            PG8_LDA(At, 0, 1); PG8_STAGE(PG8_SB(0, 0), b2, voffB); PG8_STAGE(PG8_SB(0, 1), b2 + hstep, voffB); PG8_STAGE(PG8_SA(0, 0), a2, voffA);
            PG8_WAIT_V(8); PG8_WAIT_L(0); PG8_BAR; PG8_MMA(1, 0, At, B0); PG8_MMA(1, 1, At, B1); PG8_BAR; PG8_SCHED;
            PG8_LDB(B0, 1, 0); PG8_LDB(B1, 1, 1); PG8_SCHED; PG8_LDA(At, 1, 0); PG8_STAGE(PG8_SA(0, 1), a2 + hstep, voffA);
            PG8_WAIT_V(8); PG8_WAIT_L(0); PG8_BAR; PG8_MMA(0, 0, At, B0); PG8_MMA(0, 1, At, B1); PG8_BAR; PG8_SCHED;
            PG8_LDA(At, 1, 1); PG8_STAGE(PG8_SB(1, 0), b3, voffB); PG8_STAGE(PG8_SB(1, 1), b3 + hstep, voffB); PG8_STAGE(PG8_SA(1, 0), a3, voffA);
            PG8_WAIT_V(8); PG8_WAIT_L(0); PG8_BAR; PG8_MMA(1, 0, At, B0); PG8_MMA(1, 1, At, B1); PG8_BAR; PG8_SCHED;
            } else {
            PG8_LDB(B0, 0, 0); PG8_SCHED; PG8_LDA(At, 0, 0); PG8_STAGE(PG8_SA(1, 1), a1 + hstep, voffA);
            PG8_WAIT_L(8); PG8_BAR; PG8_WAIT_L(0); PG8_MMA(0, 0, At, B0); PG8_BAR; PG8_SCHED;
            PG8_LDB(B1, 0, 1); PG8_STAGE(PG8_SB(0, 0), b2, voffB);
            PG8_BAR; PG8_WAIT_L(0); PG8_MMA(0, 1, At, B1); PG8_BAR;
            PG8_LDA(At, 0, 1); PG8_STAGE(PG8_SA(0, 0), a2, voffA);
            PG8_BAR; PG8_WAIT_L(0); PG8_MMA(1, 0, At, B0); PG8_BAR; PG8_SCHED;
            PG8_STAGE(PG8_SB(0, 1), b2 + hstep, voffB);
            PG8_WAIT_V(6); PG8_BAR; PG8_MMA(1, 1, At, B1); PG8_BAR;
            PG8_LDB(B0, 1, 0); PG8_SCHED; PG8_LDA(At, 1, 0); PG8_STAGE(PG8_SA(0, 1), a2 + hstep, voffA);
            PG8_WAIT_L(8); PG8_BAR; PG8_WAIT_L(0); PG8_MMA(0, 0, At, B0); PG8_BAR; PG8_SCHED;
            PG8_LDB(B1, 1, 1); PG8_STAGE(PG8_SB(1, 0), b3, voffB);
            PG8_BAR; PG8_WAIT_L(0); PG8_MMA(0, 1, At, B1); PG8_BAR;
            PG8_LDA(At, 1, 1); PG8_STAGE(PG8_SA(1, 0), a3, voffA);
            PG8_BAR; PG8_WAIT_L(0); PG8_MMA(1, 0, At, B0); PG8_BAR; PG8_SCHED;
            PG8_STAGE(PG8_SB(1, 1), b3 + hstep, voffB);
            PG8_WAIT_V(6); PG8_BAR; PG8_MMA(1, 1, At, B1); PG8_BAR;
            }
        }
        if constexpr (ALIGN_EPI) { if (wr == 0) PG8_BAR; }
        if constexpr (!Epi::AFTER_DRAIN) { E(acc, cur, wr, wc, fr, fq); S.done(cur); }
        if (!has_next) break;
#pragma unroll
        for (int a = 0; a < 2; ++a)
#pragma unroll
            for (int b = 0; b < 2; ++b)
#pragma unroll
                for (int m = 0; m < 4; ++m)
#pragma unroll
                    for (int n = 0; n < 2; ++n) acc[a][b][m][n] = (f32x4){0.f, 0.f, 0.f, 0.f};
        cur = nxt; cA = nA; cB = nB; ++ui;
        if constexpr (ALIGN_EPI) { if (wr == 1) PG8_BAR; }
    }
    PG8_WAIT_V(0);
    if constexpr (!ALIGN_EPI) { if (wr == 0) PG8_BAR; }
    PG8_BAR;
    if constexpr (Epi::AFTER_DRAIN) { E.fused(acc, cur, wr, wc, fr, fq, lds, wid, lane); S.done(cur); }
#undef PG8_SA
#undef PG8_SB
#undef PG8_STAGE
#undef PG8_LDA
#undef PG8_LDB
#undef PG8_MMA
#undef PG8_WAIT_V
#undef PG8_WAIT_L
#undef PG8_BAR
#undef PG8_SCHED
}
}
#define LAS __attribute__((address_space(3)))
typedef unsigned short bf16_t;
typedef short bf16x8 __attribute__((ext_vector_type(8)));
typedef float f32x4 __attribute__((ext_vector_type(4)));
typedef unsigned u32x4 __attribute__((ext_vector_type(4)));
typedef unsigned u32x2 __attribute__((ext_vector_type(2)));
typedef LAS unsigned char* ldsp;

constexpr int BATCH = 2, SEQ = 8192, DM = 1024, MROWS = BATCH * SEQ, NH = 8, HD = 64, RWW = 512;
constexpr int NPC = 4352;
constexpr int PC_R = 0, PC_K = 512, PC_V = 1024, PC_ZW = 1536, PC_ZA = 1600, PC_G = 1664, PC_PAD = 2176, PC_SQ = 2304, PC_SK = 2816, PC_SV = 3328, PC_SG = 3840;
constexpr int IN_COLS = 4224, SHIFT_COLS = 1664, NCHUNK = SEQ / 64;
constexpr size_t MiB = 1u << 20;
constexpr size_t WS_MODP = 0, WS_GATE = 786432, WS_W2T = 1 * MiB, WS_A2T = WS_W2T + 131072, WS_WIN = 2 * MiB, WS_WOUT = 19 * MiB, WS_GAM = 23 * MiB,
                 WS_H = 24 * MiB, WS_P = 56 * MiB, WS_D = 192 * MiB, WS_END = 256 * MiB;
constexpr int LDS_BYTES = 159744;
constexpr int NPHASE = 14;

struct Args { const float* in[19]; float* out; unsigned char* ws; int ph_lo, ph_hi; };

__device__ __forceinline__ unsigned f2bf(float f) { unsigned u = __builtin_bit_cast(unsigned, f); return (u + 0x7fffu + ((u >> 16) & 1u)) >> 16; }
__device__ __forceinline__ float bf2f(unsigned u) { return __builtin_bit_cast(float, u << 16); }
__device__ __forceinline__ unsigned pk2(float lo, float hi) { return pg8::cvt_pk_bf16(lo, hi); }
__device__ __forceinline__ f32x4 mfma16(bf16x8 a, bf16x8 b, f32x4 c) { return __builtin_amdgcn_mfma_f32_16x16x32_bf16(a, b, c, 0, 0, 0); }
__device__ __forceinline__ void unpack8(u32x4 w, float* o) {
    o[0] = bf2f(w.x & 0xffffu); o[1] = __builtin_bit_cast(float, w.x & 0xffff0000u); o[2] = bf2f(w.y & 0xffffu); o[3] = __builtin_bit_cast(float, w.y & 0xffff0000u);
    o[4] = bf2f(w.z & 0xffffu); o[5] = __builtin_bit_cast(float, w.z & 0xffff0000u); o[6] = bf2f(w.w & 0xffffu); o[7] = __builtin_bit_cast(float, w.w & 0xffff0000u); }
__device__ __forceinline__ f32x4 unpack4(u32x2 w) { f32x4 o; o[0] = bf2f(w.x & 0xffffu); o[1] = __builtin_bit_cast(float, w.x & 0xffff0000u); o[2] = bf2f(w.y & 0xffffu); o[3] = __builtin_bit_cast(float, w.y & 0xffff0000u); return o; }
__device__ __forceinline__ u32x2 pack4(f32x4 v) { u32x2 w; w.x = pk2(v[0], v[1]); w.y = pk2(v[2], v[3]); return w; }
__device__ __forceinline__ bf16x8 pack8(f32x4 a, f32x4 b) { u32x4 w; w.x = pk2(a[0], a[1]); w.y = pk2(a[2], a[3]); w.z = pk2(b[0], b[1]); w.w = pk2(b[2], b[3]); return __builtin_bit_cast(bf16x8, w); }
__device__ __forceinline__ float wave_sum(float v) {
#pragma unroll
    for (int o = 1; o < 64; o <<= 1) v += __shfl_xor(v, o);
    return v; }
#define WG_BAR() do { asm volatile("s_waitcnt vmcnt(0) lgkmcnt(0)" ::: "memory"); __builtin_amdgcn_s_barrier(); asm volatile("" ::: "memory"); } while (0)
#define LDS_BAR() do { asm volatile("s_waitcnt lgkmcnt(0)" ::: "memory"); __builtin_amdgcn_s_barrier(); asm volatile("" ::: "memory"); } while (0)
__device__ __forceinline__ f32x4 tile64(ldsp A, int arow, ldsp B, int brow, int q, f32x4 acc) {
#pragma unroll
    for (int ks = 0; ks < 2; ++ks) { const bf16x8 a = *(LAS const bf16x8*)(A + arow * 144 + ks * 64 + q * 16), b = *(LAS const bf16x8*)(B + brow * 144 + ks * 64 + q * 16); acc = mfma16(a, b, acc); }
    return acc; }

__device__ __forceinline__ void p0_transpose_item(const float* W, int K, int N, int src_n0, bf16_t* WT, int dst_n0, int k0, LAS float* scr, int lane) {
#pragma unroll 8
    for (int i = 0; i < 32; ++i) { const int kk = 2 * i + (lane >> 5); scr[kk * 33 + (lane & 31)] = src_n0 >= 0 ? W[(size_t)(k0 + kk) * N + src_n0 + (lane & 31)] : 0.f; }
    asm volatile("s_waitcnt lgkmcnt(0)" ::: "memory");
    const int c = lane & 7;
#pragma unroll
    for (int j = 0; j < 4; ++j) { const int n = (lane >> 3) + 8 * j; const LAS float* s = scr + (8 * c) * 33 + n;
        u32x4 o; o.x = pk2(s[0 * 33], s[1 * 33]); o.y = pk2(s[2 * 33], s[3 * 33]); o.z = pk2(s[4 * 33], s[5 * 33]); o.w = pk2(s[6 * 33], s[7 * 33]);
        *(u32x4*)(WT + (size_t)(dst_n0 + n) * K + k0 + 8 * c) = o; }
    asm volatile("s_waitcnt lgkmcnt(0)" ::: "memory");
}
__device__ __forceinline__ void phase_p0(const Args& a, ldsp lds, int tid, int lane, int wave, int G) {
    unsigned char* ws = a.ws;
    LAS float* scr = (LAS float*)(lds + wave * 16384);
    const int gw = blockIdx.x * 8 + wave, NGW = G * 8;
    constexpr int I_IN = 16 * (NPC / 32), I_OUT = 16 * (DM / 32), NITEMS = 2 * I_IN + 2 * I_OUT;
    for (int it = gw; it < NITEMS; it += NGW) {
        int r = it;
        if (r < 2 * I_IN) { const int l = r / I_IN; r -= l * I_IN; const int kb = r / (NPC / 32), nb = r % (NPC / 32); const int dn = 32 * nb;
            const int sn = dn < PC_PAD ? dn : (dn < PC_SQ ? -1 : dn - 128);
            p0_transpose_item(a.in[5] + (size_t)l * DM * IN_COLS, DM, IN_COLS, sn, (bf16_t*)(ws + WS_WIN) + (size_t)l * NPC * DM, dn, 64 * kb, scr, lane); }
        else { r -= 2 * I_IN; const int l = r / I_OUT; r -= l * I_OUT; const int kb = r / (DM / 32), nb = r % (DM / 32);
            p0_transpose_item(a.in[6] + (size_t)l * DM * DM, DM, DM, 32 * nb, (bf16_t*)(ws + WS_WOUT) + (size_t)l * DM * DM, 32 * nb, 64 * kb, scr, lane); }
    }
    { const int gt = blockIdx.x * 512 + tid, NT = G * 512;
      for (int o = gt; o < 2 * 65536; o += NT) { const int which = o >> 16, rem = o & 65535, l = rem >> 15, r2 = rem & 32767, n = r2 >> 6, m = r2 & 63;
          const float v = a.in[which ? 11 : 9][(size_t)(l * 64 + m) * 512 + n];
          ((bf16_t*)(ws + (which ? WS_A2T : WS_W2T)))[rem] = (bf16_t)f2bf(v); } }
    WG_BAR();
    LAS float* red = (LAS float*)lds;
    for (int unit = blockIdx.x; unit < 384; unit += G) {
        const int l = unit / 192, r = unit % 192, kp = r / 12, ncb = r % 12;
        const int n = ncb * 256 + (tid & 255), kh = tid >> 8, kbeg = kp * 64 + kh * 32;
        const float* W = a.in[3] + (size_t)l * DM * 3072 + n; const float* c0 = a.in[1]; const float* c1 = a.in[1] + DM;
        float a0 = 0.f, a1 = 0.f;
#pragma unroll 8
        for (int k = kbeg; k < kbeg + 32; ++k) { const float w = W[(size_t)k * 3072]; const float x0 = c0[k], x1 = c1[k];
            a0 += x0 / (1.f + __expf(-x0)) * w; a1 += x1 / (1.f + __expf(-x1)) * w; }
        if (kh == 1) { red[tid & 255] = a0; red[256 + (tid & 255)] = a1; }
        LDS_BAR();
        if (kh == 0) { float* mp = (float*)(ws + WS_MODP) + (size_t)((l * 16 + kp) * 2) * 3072 + n; mp[0] = a0 + red[tid]; mp[3072] = a1 + red[256 + tid]; }
        LDS_BAR();
    }
}

__device__ __forceinline__ void phase_h(const Args& a, ldsp lds, int l, const float* xin, int tid, int lane, int wave, int G) {
    unsigned char* ws = a.ws;
    LAS float* sc = (LAS float*)lds; LAS float* sh = sc + 2048;
    const float* modp = (const float*)(ws + WS_MODP) + (size_t)l * 16 * 2 * 3072; const float* adab = a.in[4] + l * 3072; const float* ng = a.in[2] + l * DM;
    for (int idx = tid; idx < 2048; idx += 512) { const int b = idx >> 10, k = idx & 1023; float s0 = adab[k], s1 = adab[1024 + k], s2 = adab[2048 + k];
        for (int kp = 0; kp < 16; ++kp) { const float* mp = modp + (size_t)(kp * 2 + b) * 3072; s0 += mp[k]; s1 += mp[1024 + k]; s2 += mp[2048 + k]; }
        sh[idx] = s0; sc[idx] = ng[k] * (1.f + s1);
        if (blockIdx.x == 0) ((float*)(ws + WS_GATE))[(l * 2 + b) * 1024 + k] = s2; }
    LDS_BAR();
    bf16_t* H = (bf16_t*)(ws + WS_H);
    const int gw = blockIdx.x * 8 + wave, NGW = G * 8;
    for (int m = gw; m < MROWS; m += NGW) {
        const f32x4* xr = (const f32x4*)(xin + (size_t)m * DM) + lane; const int b = m >> 13;
        f32x4 v[4]; float s = 0.f;
#pragma unroll
        for (int j = 0; j < 4; ++j) { v[j] = xr[64 * j]; s += (v[j][0] * v[j][0] + v[j][1] * v[j][1]) + (v[j][2] * v[j][2] + v[j][3] * v[j][3]); }
        const float rstd = 1.0f / sqrtf(wave_sum(s) * (1.f / DM) + 1e-6f);
        unsigned long long* o8 = (unsigned long long*)(H + (size_t)m * DM) + lane;
#pragma unroll
        for (int j = 0; j < 4; ++j) { const int k = 4 * lane + 256 * j; const f32x4 scv = *(LAS const f32x4*)(sc + b * 1024 + k), shv = *(LAS const f32x4*)(sh + b * 1024 + k);
            const f32x4 hv = v[j] * rstd * scv + shv; o8[64 * j] = (unsigned long long)pk2(hv[0], hv[1]) | ((unsigned long long)pk2(hv[2], hv[3]) << 32); }
    }
}
constexpr int L_RS = 0, L_KS = 16384, L_PB = 0, L_PTB = 9216, L_TB = 18432, L_TZW = 32768, L_ZA = 32768 + 9216, L_XT = 32768, L_C = 32768 + 18432;
constexpr int L_AG = L_C, L_RG = L_C + 9216, L_BG = L_C + 2 * 9216, L_KG = L_C + 3 * 9216, L_AGT = L_C + 4 * 9216, L_BTT = L_C + 5 * 9216, L_KTT = L_C + 6 * 9216, L_VT = L_C + 7 * 9216;
constexpr int L_D = L_C + 8 * 9216, L_AAK = L_D, L_ARB = L_D + 9216, L_ARK = L_D + 2 * 9216, L_MISC = L_D + 3 * 9216, L_AKVT = L_BG;
static_assert(L_MISC + 2048 <= LDS_BYTES, "R1 LDS map");
__device__ __forceinline__ float fexp(float x) { return __builtin_amdgcn_exp2f(x * 1.4426950408889634f); }
__device__ __forceinline__ float flog(float x) { return __builtin_amdgcn_logf(x) * 0.6931471805599453f; }
__device__ __forceinline__ float frcp(float x) { return __builtin_amdgcn_rcpf(x); }
__device__ __forceinline__ float tanh_f(float x) { return 1.f - 2.f * frcp(fexp(2.f * x) + 1.f); }
__device__ __forceinline__ void st16(ldsp p, float v) { *(LAS bf16_t*)p = (bf16_t)f2bf(v); }

#ifdef DBG_CHECK
constexpr size_t WS_DBG = 23 * MiB + 512 * 1024;
constexpr size_t WS_DUMP = WS_DBG + 256 * 1024;
__device__ __forceinline__ void dbg_dump(unsigned char* ws, ldsp lds, int l, int u, int tid, int ldsoff, int bytes, int dstoff) {
    if (l == 0 && u == 0) { for (int i = tid * 4; i < bytes; i += 2048) *(unsigned*)(ws + WS_DUMP + dstoff + i) = *(LAS const unsigned*)(lds + ldsoff + i); }
}
#define DBG_DUMP(ldsoff, bytes, dstoff) dbg_dump(ws, lds, l, u, tid, ldsoff, bytes, dstoff)
#else
#define DBG_DUMP(ldsoff, bytes, dstoff) do { } while (0)
#endif
__device__ __forceinline__ void r1_load(const Args& a, int l, int u, int tid, u32x4 (&rc)[5], u32x4 (&rp)[5]) {
    const int b = u >> 10, h = (u >> 7) & 7, c = u & 127, tt = tid >> 3, part = tid & 7, row = b * SEQ + c * 64 + tt; const bool hasprev = !(c == 0 && tt == 0);
    const bf16_t* prow = (const bf16_t*)(a.ws + WS_P) + (size_t)row * NPC; const bf16_t* pprev = prow - NPC;
    const int cols[5] = {PC_R + h * 64 + part * 8, PC_K + h * 64 + part * 8, PC_V + h * 64 + part * 8, PC_ZW + part * 8, PC_ZA + part * 8};
#pragma unroll
    for (int g = 0; g < 5; ++g) { rc[g] = *(const u32x4*)(prow + cols[g]); rp[g] = hasprev ? *(const u32x4*)(pprev + cols[g]) : (u32x4){0u, 0u, 0u, 0u}; }
}
__device__ __forceinline__ void r1_unit(const Args& a, ldsp lds, int l, int u, int unext, int tid, int lane, int wave, u32x4 (&rc)[5], u32x4 (&rp)[5]) {
    unsigned char* ws = a.ws;
    const int b = u >> 10, h = (u >> 7) & 7, c = u & 127, row0 = b * SEQ + c * 64, l15 = lane & 15, q = lane >> 4;
    bf16_t* P = (bf16_t*)(ws + WS_P);
    LAS float* RS = (LAS float*)(lds + L_RS); LAS float* KS = (LAS float*)(lds + L_KS);
    LAS float* rnorm = (LAS float*)(lds + L_MISC); LAS float* bonp = rnorm + 64;
    {
        const int tt = tid >> 3, part = tid & 7; const float* mu = a.in[7] + l * SHIFT_COLS;
        float cur[8], prv[8], ps[8];
#define R1_SHIFT(g, col) do { unpack8(rc[g], cur); unpack8(rp[g], prv); \
        const f32x4 m0 = *(const f32x4*)(mu + (col)), m1 = *(const f32x4*)(mu + (col) + 4); \
        _Pragma("unroll") for (int e = 0; e < 4; ++e) { ps[e] = cur[e] + (prv[e] - cur[e]) * m0[e]; ps[4 + e] = cur[4 + e] + (prv[4 + e] - cur[4 + e]) * m1[e]; } } while (0)
        R1_SHIFT(0, PC_R + h * 64 + part * 8);
        *(LAS f32x4*)(RS + tt * 64 + part * 8) = (f32x4){ps[0], ps[1], ps[2], ps[3]}; *(LAS f32x4*)(RS + tt * 64 + part * 8 + 4) = (f32x4){ps[4], ps[5], ps[6], ps[7]};
        R1_SHIFT(1, PC_K + h * 64 + part * 8);
        *(LAS f32x4*)(KS + tt * 64 + part * 8) = (f32x4){ps[0], ps[1], ps[2], ps[3]}; *(LAS f32x4*)(KS + tt * 64 + part * 8 + 4) = (f32x4){ps[4], ps[5], ps[6], ps[7]};
        { const float* kkp = a.in[12] + l * RWW + h * 64 + part * 8; float ss = 0.f;
#pragma unroll
          for (int e = 0; e < 8; ++e) { const float t = ps[e] * kkp[e]; ss += t * t; }
          ss += __shfl_xor(ss, 1); ss += __shfl_xor(ss, 2); ss += __shfl_xor(ss, 4);
          if (part == 0) rnorm[tt] = __builtin_amdgcn_rsqf(fmaxf(ss, 1e-24f)); }
        R1_SHIFT(2, PC_V + h * 64 + part * 8);
#pragma unroll
        for (int e = 0; e < 8; ++e) st16(lds + L_VT + (part * 8 + e) * 144 + tt * 2, ps[e]);
        R1_SHIFT(3, PC_ZW + part * 8);
        { u32x4 w; w.x = pk2(tanh_f(ps[0]), tanh_f(ps[1])); w.y = pk2(tanh_f(ps[2]), tanh_f(ps[3])); w.z = pk2(tanh_f(ps[4]), tanh_f(ps[5])); w.w = pk2(tanh_f(ps[6]), tanh_f(ps[7]));
          *(LAS u32x4*)(lds + L_TZW + tt * 144 + part * 16) = w; }
        R1_SHIFT(4, PC_ZA + part * 8);
        { u32x4 w; w.x = pk2(ps[0], ps[1]); w.y = pk2(ps[2], ps[3]); w.z = pk2(ps[4], ps[5]); w.w = pk2(ps[6], ps[7]); *(LAS u32x4*)(lds + L_ZA + tt * 144 + part * 16) = w; }
#undef R1_SHIFT
    }
    LDS_BAR();
    {
        const int ct = wave & 3, th = wave >> 2, jl = 16 * ct + l15, jg = h * 64 + jl;
        f32x4 wacc[2], aacc[2];
        { const bf16_t* w2t = (const bf16_t*)(ws + WS_W2T) + ((size_t)l * 512 + jg) * 64; const bf16_t* a2t = (const bf16_t*)(ws + WS_A2T) + ((size_t)l * 512 + jg) * 64;
          bf16x8 bw[2], ba[2];
#pragma unroll
          for (int ks = 0; ks < 2; ++ks) { bw[ks] = *(const bf16x8*)(w2t + 32 * ks + 8 * q); ba[ks] = *(const bf16x8*)(a2t + 32 * ks + 8 * q); }
#pragma unroll
          for (int m2 = 0; m2 < 2; ++m2) { const int mt = 2 * th + m2; wacc[m2] = (f32x4){0.f, 0.f, 0.f, 0.f}; aacc[m2] = (f32x4){0.f, 0.f, 0.f, 0.f};
#pragma unroll
              for (int ks = 0; ks < 2; ++ks) { const bf16x8 a1 = *(LAS const bf16x8*)(lds + L_TZW + (16 * mt + l15) * 144 + ks * 64 + q * 16), a2 = *(LAS const bf16x8*)(lds + L_ZA + (16 * mt + l15) * 144 + ks * 64 + q * 16);
                  wacc[m2] = mfma16(a1, bw[ks], wacc[m2]); aacc[m2] = mfma16(a2, ba[ks], aacc[m2]); } } }
        const float w0v = a.in[8][l * RWW + jg], a0v = a.in[10][l * RWW + jg], kkv = a.in[12][l * RWW + jg], kav = a.in[13][l * RWW + jg], rkv = a.in[14][l * RWW + jg];
        f32x4 ldv[2], cin[2]; float carry = 0.f;
#pragma unroll
        for (int m2 = 0; m2 < 2; ++m2) {
#pragma unroll
            for (int r = 0; r < 4; ++r) { const float wa = w0v + wacc[m2][r]; const float sp = fmaxf(-wa, 0.f) + flog(1.f + fexp(-fabsf(wa)));
                ldv[m2][r] = -fexp(-sp - 0.5f);
                aacc[m2][r] = frcp(1.f + fexp(-(a0v + aacc[m2][r]))); }
            const float p0 = ldv[m2][0], p1 = p0 + ldv[m2][1], p2 = p1 + ldv[m2][2], p3 = p2 + ldv[m2][3];
            const float t0 = __shfl(p3, l15), t1 = __shfl(p3, l15 + 16), t2 = __shfl(p3, l15 + 32), t3 = __shfl(p3, l15 + 48);
            const float base = carry + (q > 0 ? t0 : 0.f) + (q > 1 ? t1 : 0.f) + (q > 2 ? t2 : 0.f);
            cin[m2] = (f32x4){base + p0, base + p1, base + p2, base + p3}; carry += (t0 + t1) + (t2 + t3);
        }
        LAS float* htot = (LAS float*)(lds + L_MISC + 1536);
        if (q == 0) htot[th * 64 + jl] = carry;
        LDS_BAR();
        const float lo_ = htot[jl], hi_ = htot[64 + jl], ctot = lo_ + hi_, base0 = th ? lo_ : 0.f;
#pragma unroll
        for (int m2 = 0; m2 < 2; ++m2) { const int mt = 2 * th + m2; f32x4 agt, btt, ktt;
#pragma unroll
            for (int r = 0; r < 4; ++r) { const int t = 16 * mt + 4 * q + r; const float rr = RS[t * 64 + jl], kr = KS[t * 64 + jl], rn = rnorm[t];
                const float kk = kr * kkv * rn, av = aacc[m2][r], bq = kk * av, kp = kr * (1.f + (av - 1.f) * kav);
                const float ci = cin[m2][r] + base0, e_in = fexp(ci), e_ex = fexp(ci - ldv[m2][r]), e_ni = fexp(-ci), e_t = fexp(ctot - ci);
                const float Ag = -kk * e_ex, Rg = rr * e_in, Bg = bq * e_ni, Kg = kp * e_ni; agt[r] = Ag; btt[r] = bq * e_t; ktt[r] = kp * e_t;
                st16(lds + L_AG + t * 144 + jl * 2, Ag); st16(lds + L_RG + t * 144 + jl * 2, Rg); st16(lds + L_BG + t * 144 + jl * 2, Bg); st16(lds + L_KG + t * 144 + jl * 2, Kg);
                float bon = rr * kp * rkv; bon += __shfl_xor(bon, 1); bon += __shfl_xor(bon, 2); bon += __shfl_xor(bon, 4); bon += __shfl_xor(bon, 8);
                if (l15 == 0) bonp[ct * 64 + t] = bon; }
            *(LAS u32x2*)(lds + L_AGT + jl * 144 + (16 * mt + 4 * q) * 2) = pack4(agt); *(LAS u32x2*)(lds + L_BTT + jl * 144 + (16 * mt + 4 * q) * 2) = pack4(btt);
            *(LAS u32x2*)(lds + L_KTT + jl * 144 + (16 * mt + 4 * q) * 2) = pack4(ktt); }
        if (th == 0 && q == 0) ((float*)(ws + WS_GAM))[(size_t)u * 64 + jl] = fexp(ctot);
    }
    LDS_BAR();
    if (unext >= 0) r1_load(a, l, unext, tid, rc, rp);
    DBG_DUMP(L_C, 73728, 0);
    if (tid < 64) { const float bs = (bonp[tid] + bonp[64 + tid]) + (bonp[128 + tid] + bonp[192 + tid]); *(float*)((unsigned char*)(P + (size_t)(row0 + tid) * NPC + PC_PAD) + h * 4) = bs; }
    { const int blk = wave & 3, half = wave >> 2; const int aoff = (blk & 1) ? L_KG : L_BG, boff = (blk & 2) ? L_RG : L_AG;
      const int dest = blk == 0 ? L_PB : (blk == 1 ? L_AAK : (blk == 2 ? L_ARB : L_ARK));
#pragma unroll 1
      for (int i = 0; i < 8; ++i) { const int ti = 2 * i + half, mt = ti >> 2, nt = ti & 3; f32x4 acc = (f32x4){0.f, 0.f, 0.f, 0.f};
          if (mt <= nt) acc = tile64(lds + aoff, 16 * mt + l15, lds + boff, 16 * nt + l15, q, acc);
          const int t = 16 * nt + l15, tb = 16 * mt + 4 * q;
#pragma unroll
          for (int r = 0; r < 4; ++r) { const bool keep = (blk < 2) ? (tb + r < t) : (tb + r <= t); acc[r] = keep ? acc[r] : 0.f; }
          *(LAS u32x2*)(lds + dest + t * 144 + tb * 2) = pack4(acc);
          if (blk == 0) {
#pragma unroll
              for (int r = 0; r < 4; ++r) st16(lds + L_PTB + (tb + r) * 144 + t * 2, acc[r]); } } }
    LDS_BAR();
    DBG_DUMP(L_PB, 18432, 73728); DBG_DUMP(L_D, 27648, 73728 + 18432);
#pragma unroll
    for (int i = 0; i < 2; ++i) { const int id = wave * 2 + i, mt = id >> 2, nt = id & 3; f32x4 acc = (f32x4){0.f, 0.f, 0.f, 0.f};
        acc = tile64(lds + L_AAK, 16 * mt + l15, lds + L_VT, 16 * nt + l15, q, acc);
        *(LAS u32x2*)(lds + L_AKVT + (16 * nt + l15) * 144 + (16 * mt + 4 * q) * 2) = pack4(acc); }
#ifdef DBG_CHECK
    LDS_BAR(); DBG_DUMP(L_AKVT, 9216, -49152); LDS_BAR();
#endif
    {
        const bf16x8 z8 = {0, 0, 0, 0, 0, 0, 0, 0};
        if (wave < 4) { const int i = wave; ldsp pb = lds + L_PB + (16 * i) * 144 + 32 * i, pt = lds + L_PTB + (16 * i) * 144 + 32 * i, tb = lds + L_TB + (16 * i) * 144 + 32 * i;
            f32x4 Tacc;
#pragma unroll
            for (int r = 0; r < 4; ++r) Tacc[r] = bf2f(*(LAS const bf16_t*)(pb + (4 * q + r) * 144 + l15 * 2)) + ((4 * q + r) == l15 ? 1.f : 0.f);
#pragma unroll
            for (int round = 0; round < 3; ++round) {
                const bf16x8 pa = q < 2 ? *(LAS const bf16x8*)(pb + l15 * 144 + 16 * q) : z8, pbt = q < 2 ? *(LAS const bf16x8*)(pt + l15 * 144 + 16 * q) : z8;
                const f32x4 Pn = mfma16(pa, pbt, (f32x4){0.f, 0.f, 0.f, 0.f});
#pragma unroll
                for (int r = 0; r < 4; ++r) { st16(pb + (4 * q + r) * 144 + l15 * 2, Pn[r]); st16(tb + (4 * q + r) * 144 + l15 * 2, Tacc[r]); }
                *(LAS u32x2*)(pt + l15 * 144 + 8 * q) = pack4(Pn);
                asm volatile("s_waitcnt lgkmcnt(0)" ::: "memory");
                const bf16x8 ta = q < 2 ? *(LAS const bf16x8*)(tb + l15 * 144 + 16 * q) : z8, pnt = q < 2 ? *(LAS const bf16x8*)(pt + l15 * 144 + 16 * q) : z8;
                Tacc = mfma16(ta, pnt, Tacc);
            }
#pragma unroll
            for (int r = 0; r < 4; ++r) st16(tb + (4 * q + r) * 144 + l15 * 2, Tacc[r]);
            *(LAS u32x2*)(pt + l15 * 144 + 8 * q) = pack4(Tacc);
        } else {
            for (int k = wave - 4; k < 6; k += 4) { const int bi = k < 3 ? 0 : (k < 5 ? 1 : 2), bj = k < 3 ? k + 1 : (k < 5 ? k - 1 : 3);
                *(LAS unsigned*)(lds + L_TB + (16 * bi + (lane >> 2)) * 144 + 32 * bj + (lane & 3) * 8) = 0u; *(LAS unsigned*)(lds + L_TB + (16 * bi + (lane >> 2)) * 144 + 32 * bj + (lane & 3) * 8 + 4) = 0u; }
        }
        LDS_BAR();
#pragma unroll
        for (int d = 1; d < 4; ++d) {
            if (wave < 4 - d) { const int i = wave + d, j = wave; ldsp scr = lds + 27648 + wave * 512;
                f32x4 M = (f32x4){0.f, 0.f, 0.f, 0.f};
#pragma unroll
                for (int ks = 0; ks < (d + 1) / 2; ++ks) { const bool on = (32 * ks + 8 * q) < 16 * d;
                    const bf16x8 aa = on ? *(LAS const bf16x8*)(lds + L_PB + (16 * i + l15) * 144 + (16 * j + 32 * ks + 8 * q) * 2) : z8, bb = on ? *(LAS const bf16x8*)(lds + L_PTB + (16 * j + l15) * 144 + (16 * j + 32 * ks + 8 * q) * 2) : z8;
                    M = mfma16(aa, bb, M); }
                *(LAS u32x2*)(scr + l15 * 32 + 8 * q) = pack4(M);
                asm volatile("s_waitcnt lgkmcnt(0)" ::: "memory");
                const bf16x8 da = q < 2 ? *(LAS const bf16x8*)(lds + L_TB + (16 * i + l15) * 144 + (16 * i + 8 * q) * 2) : z8, mb = q < 2 ? *(LAS const bf16x8*)(scr + l15 * 32 + 16 * q) : z8;
                const f32x4 Tij = mfma16(da, mb, (f32x4){0.f, 0.f, 0.f, 0.f});
#pragma unroll
                for (int r = 0; r < 4; ++r) st16(lds + L_TB + (16 * i + 4 * q + r) * 144 + (16 * j + l15) * 2, Tij[r]);
                *(LAS u32x2*)(lds + L_PTB + (16 * j + l15) * 144 + (16 * i + 4 * q) * 2) = pack4(Tij);
            }
            if (d < 3) LDS_BAR();
        }
    }
    LDS_BAR();
    DBG_DUMP(L_TB, 9216, 119808); DBG_DUMP(L_AKVT, 9216, 129024);
#pragma unroll 1
    for (int i = 0; i < 4; ++i) { const int id = wave * 4 + i, mt = id & 3, nt = id >> 2; f32x4 acc = (f32x4){0.f, 0.f, 0.f, 0.f};
        acc = tile64(lds + L_TB, 16 * mt + l15, nt < 4 ? lds + L_AGT : lds + L_AKVT, 16 * (nt & 3) + l15, q, acc);
        *(LAS u32x2*)(lds + L_XT + (16 * nt + l15) * 144 + (16 * mt + 4 * q) * 2) = pack4(acc); }
    LDS_BAR();
    DBG_DUMP(L_XT, 18432, 138240);
    { unsigned char* Du = ws + WS_D + (size_t)u * 32768; const int kind = wave >> 1;
#pragma unroll 1
      for (int i = 0; i < 8; ++i) { const int id = (wave & 1) * 8 + i, mt = id & 3, nt = id >> 2; f32x4 acc = (f32x4){0.f, 0.f, 0.f, 0.f}; const int row = 16 * nt + l15;
          if (kind == 0) { acc = tile64(lds + L_XT, 16 * mt + l15, lds + L_BTT, row, q, acc); }
          else if (kind == 1) { acc = tile64(lds + L_XT, 16 * mt + l15, lds + L_ARB, row, q, acc); acc += unpack4(*(LAS const u32x2*)(lds + L_RG + row * 144 + (16 * mt + 4 * q) * 2)); }
          else if (kind == 2) { acc = tile64(lds + L_BTT, 16 * mt + l15, lds + L_XT, 64 + row, q, acc); acc = tile64(lds + L_KTT, 16 * mt + l15, lds + L_VT, row, q, acc); }
          else { acc = tile64(lds + L_XT, 64 + 16 * mt + l15, lds + L_ARB, row, q, acc); acc = tile64(lds + L_VT, 16 * mt + l15, lds + L_ARK, row, q, acc); }
          const int sw = (row >> 1) & 7;
          const int off = kind < 2 ? row * 128 + (((4 * (mt >> 1) + q) ^ sw) * 16) + 8 * (mt & 1) : row * 128 + (((2 * mt + (q >> 1)) ^ sw) * 16) + 8 * (q & 1);
          *(u32x2*)(Du + kind * 8192 + off) = pack4(acc); } }
    LDS_BAR();
}

__device__ __forceinline__ void sb_task(const Args& a, ldsp vs, int l, int task, int lane) {
    unsigned char* ws = a.ws; const bf16_t* P = (const bf16_t*)(ws + WS_P); bf16_t* Y = (bf16_t*)(ws + WS_H);
    const int bh = task >> 8, qt = task & 255, b = bh >> 3, h = bh & 7, q0 = qt * 32, rowb = b * SEQ, l15 = lane & 15, q = lane >> 4;
    bf16x8 bq[2][2];
#pragma unroll
    for (int qi = 0; qi < 2; ++qi)
#pragma unroll
        for (int ks = 0; ks < 2; ++ks) bq[qi][ks] = *(const bf16x8*)(P + (size_t)(rowb + q0 + 16 * qi + l15) * NPC + PC_SQ + h * 64 + 32 * ks + 8 * q);
    bf16x8 am[2];
#pragma unroll
    for (int mt = 0; mt < 2; ++mt)
#pragma unroll
        for (int e = 0; e < 8; ++e) am[mt][e] = ((16 * (e >> 2) + 4 * q + (e & 3)) > (16 * mt + l15)) ? (short)0x3F80 : (short)0;
    f32x4 O[2][4];
#pragma unroll
    for (int qi = 0; qi < 2; ++qi)
#pragma unroll
        for (int nt = 0; nt < 4; ++nt) O[qi][nt] = (f32x4){0.f, 0.f, 0.f, 0.f};
    float carry[2] = {0.f, 0.f};
    int kb = qt;
    bf16x8 kA[2][2], kN[2][2]; u32x4 vR[4], vN[4];
#define SB_LOAD(KA, VR, kbv) do { _Pragma("unroll") for (int mt = 0; mt < 2; ++mt) _Pragma("unroll") for (int ks = 0; ks < 2; ++ks) \
        KA[mt][ks] = *(const bf16x8*)(P + (size_t)(rowb + 32 * (kbv) + 16 * mt + l15) * NPC + PC_SK + h * 64 + 32 * ks + 8 * q); \
        _Pragma("unroll") for (int i = 0; i < 4; ++i) { const int pi = lane + 64 * i; VR[i] = *(const u32x4*)(P + (size_t)(rowb + 32 * (kbv) + (pi >> 3)) * NPC + PC_SV + h * 64 + (pi & 7) * 8); } } while (0)
    SB_LOAD(kA, vR, kb);
    for (;;) {
#pragma unroll
        for (int i = 0; i < 4; ++i) { const int pi = lane + 64 * i; *(LAS u32x4*)(vs + (pi >> 3) * 144 + (pi & 7) * 16) = vR[i]; }
        if (kb > 0) SB_LOAD(kN, vN, kb - 1);
        bf16x8 Wop[2];
#pragma unroll
        for (int qi = 0; qi < 2; ++qi) { const int t = q0 + 16 * qi + l15;
            f32x4 ell[2], lsz[2]; bool valid[2][4];
#pragma unroll
            for (int mt = 0; mt < 2; ++mt) { f32x4 z = (f32x4){0.f, 0.f, 0.f, 0.f}; z = mfma16(kA[mt][0], bq[qi][0], z); z = mfma16(kA[mt][1], bq[qi][1], z);
#pragma unroll
                for (int r = 0; r < 4; ++r) { const int s = 32 * kb + 16 * mt + 4 * q + r; const float zz = z[r] * 0.125f; const float sp = fmaxf(zz, 0.f) + flog(1.f + fexp(-fabsf(zz)));
                    valid[mt][r] = s < t; ell[mt][r] = valid[mt][r] ? -sp : 0.f; lsz[mt][r] = zz - sp; } }
            const bf16x8 Lhi = pack8(ell[0], ell[1]);
            f32x4 lo0, lo1; { const u32x4 w = __builtin_bit_cast(u32x4, Lhi);
                lo0[0] = ell[0][0] - bf2f(w.x & 0xffffu); lo0[1] = ell[0][1] - __builtin_bit_cast(float, w.x & 0xffff0000u); lo0[2] = ell[0][2] - bf2f(w.y & 0xffffu); lo0[3] = ell[0][3] - __builtin_bit_cast(float, w.y & 0xffff0000u);
                lo1[0] = ell[1][0] - bf2f(w.z & 0xffffu); lo1[1] = ell[1][1] - __builtin_bit_cast(float, w.z & 0xffff0000u); lo1[2] = ell[1][2] - bf2f(w.w & 0xffffu); lo1[3] = ell[1][3] - __builtin_bit_cast(float, w.w & 0xffff0000u); }
            const bf16x8 Llo = pack8(lo0, lo1);
            f32x4 aft[2], wv[2];
#pragma unroll
            for (int mt = 0; mt < 2; ++mt) { aft[mt] = (f32x4){0.f, 0.f, 0.f, 0.f}; aft[mt] = mfma16(am[mt], Lhi, aft[mt]); aft[mt] = mfma16(am[mt], Llo, aft[mt]);
#pragma unroll
                for (int r = 0; r < 4; ++r) wv[mt][r] = valid[mt][r] ? fexp(lsz[mt][r] + aft[mt][r] + carry[qi]) : 0.f; }
            carry[qi] += __shfl(aft[0][0] + ell[0][0], l15);
            Wop[qi] = pack8(wv[0], wv[1]); }
        {
          typedef short s16x4 __attribute__((ext_vector_type(4)));
          s16x4 v00, v01, v10, v11, v20, v21, v30, v31;
          const unsigned va = (unsigned)(size_t)(vs + (4 * q + (l15 >> 2)) * 144 + 8 * (lane & 3));
          asm volatile("s_waitcnt lgkmcnt(0)\n\tds_read_b64_tr_b16 %0, %8\n\tds_read_b64_tr_b16 %1, %8 offset:2304\n\tds_read_b64_tr_b16 %2, %8 offset:32\n\tds_read_b64_tr_b16 %3, %8 offset:2336\n\t"
                       "ds_read_b64_tr_b16 %4, %8 offset:64\n\tds_read_b64_tr_b16 %5, %8 offset:2368\n\tds_read_b64_tr_b16 %6, %8 offset:96\n\tds_read_b64_tr_b16 %7, %8 offset:2400\n\ts_waitcnt lgkmcnt(0)"
                       : "=&v"(v00), "=&v"(v01), "=&v"(v10), "=&v"(v11), "=&v"(v20), "=&v"(v21), "=&v"(v30), "=&v"(v31) : "v"(va) : "memory");
          const bf16x8 vb0 = __builtin_shufflevector(v00, v01, 0, 1, 2, 3, 4, 5, 6, 7), vb1 = __builtin_shufflevector(v10, v11, 0, 1, 2, 3, 4, 5, 6, 7), vb2 = __builtin_shufflevector(v20, v21, 0, 1, 2, 3, 4, 5, 6, 7), vb3 = __builtin_shufflevector(v30, v31, 0, 1, 2, 3, 4, 5, 6, 7);
#pragma unroll
          for (int qi = 0; qi < 2; ++qi) { O[qi][0] = mfma16(Wop[qi], vb0, O[qi][0]); O[qi][1] = mfma16(Wop[qi], vb1, O[qi][1]); O[qi][2] = mfma16(Wop[qi], vb2, O[qi][2]); O[qi][3] = mfma16(Wop[qi], vb3, O[qi][3]); } }
        if (kb == 0) break;
        if (__all(carry[0] < -100.f && carry[1] < -100.f)) break;
        --kb;
#pragma unroll
        for (int mt = 0; mt < 2; ++mt)
#pragma unroll
            for (int ks = 0; ks < 2; ++ks) kA[mt][ks] = kN[mt][ks];
#pragma unroll
        for (int i = 0; i < 4; ++i) vR[i] = vN[i];
    }
#undef SB_LOAD
    const float* sbg = a.in[17] + l * 512 + h * 64;
#pragma unroll
    for (int qi = 0; qi < 2; ++qi)
#pragma unroll
    for (int r = 0; r < 4; ++r) { float ss = (O[qi][0][r] * O[qi][0][r] + O[qi][1][r] * O[qi][1][r]) + (O[qi][2][r] * O[qi][2][r] + O[qi][3][r] * O[qi][3][r]);
        ss += __shfl_xor(ss, 1); ss += __shfl_xor(ss, 2); ss += __shfl_xor(ss, 4); ss += __shfl_xor(ss, 8);
        const float rms = __builtin_amdgcn_rsqf(ss * (1.f / 64.f) + 1e-6f); const int tq = q0 + 16 * qi + 4 * q + r;
        const size_t row = (size_t)(rowb + ((tq & 127) << 6) + (tq >> 7));
#pragma unroll
        for (int nt = 0; nt < 4; ++nt) { const int d = 16 * nt + l15; const float g = bf2f(P[row * NPC + PC_SG + h * 64 + d]);
            float yv = O[qi][nt][r] * rms * sbg[d] * (g * frcp(1.f + fexp(-g)));
            Y[row * DM + 512 + h * 64 + d] = (bf16_t)f2bf(yv); } }
}

constexpr int R2_SLOT = 10496, R2_NS = 12, R2_PD = 10;
__device__ __forceinline__ void phase_r2(const Args& a, ldsp lds, int tid, int lane, int wave) {
    unsigned char* ws = a.ws; const int bh = blockIdx.x >> 2, ig = blockIdx.x & 3, b = bh >> 3, h = bh & 7, u0 = bh * NCHUNK, l15 = lane & 15, q = lane >> 4;
    const unsigned char* Dg = ws + WS_D + (size_t)u0 * 32768; const unsigned char* Gg = ws + WS_GAM + (size_t)u0 * 256;
    if (wave == 1) {
#define R2_ISSUE_A(cc) do { const int c_ = (cc) < NCHUNK ? (cc) : NCHUNK - 1; const int sl_ = ((cc) % R2_NS) * R2_SLOT; _Pragma("unroll") for (int i = 0; i < 6; ++i) \
        __builtin_amdgcn_global_load_lds((const unsigned*)(Dg + (size_t)c_ * 32768 + i * 1024 + lane * 16), (LAS unsigned*)(lds + sl_ + i * 1024), 16, 0, 0); } while (0)
        for (int c = 0; c < R2_PD; ++c) R2_ISSUE_A(c);
        asm volatile("s_waitcnt vmcnt(54)" ::: "memory");
        __builtin_amdgcn_s_barrier();
        for (int c = 0; c < NCHUNK; ++c) { R2_ISSUE_A(c + R2_PD); asm volatile("s_waitcnt vmcnt(54)" ::: "memory"); __builtin_amdgcn_s_barrier(); }
        asm volatile("s_waitcnt vmcnt(0)" ::: "memory");
#undef R2_ISSUE_A
    } else if (wave == 2) {
#define R2_ISSUE_B(cc) do { const int c_ = (cc) < NCHUNK ? (cc) : NCHUNK - 1; const int sl_ = ((cc) % R2_NS) * R2_SLOT; const unsigned char* du_ = Dg + (size_t)c_ * 32768; \
        __builtin_amdgcn_global_load_lds((const unsigned*)(du_ + 6 * 1024 + lane * 16), (LAS unsigned*)(lds + sl_ + 6 * 1024), 16, 0, 0); \
        __builtin_amdgcn_global_load_lds((const unsigned*)(du_ + 7 * 1024 + lane * 16), (LAS unsigned*)(lds + sl_ + 7 * 1024), 16, 0, 0); \
        __builtin_amdgcn_global_load_lds((const unsigned*)(du_ + 16384 + ig * 2048 + lane * 16), (LAS unsigned*)(lds + sl_ + 8192), 16, 0, 0); \
        __builtin_amdgcn_global_load_lds((const unsigned*)(du_ + 16384 + ig * 2048 + 1024 + lane * 16), (LAS unsigned*)(lds + sl_ + 9216), 16, 0, 0); \
        if (lane < 16) __builtin_amdgcn_global_load_lds((const unsigned*)(Gg + (size_t)c_ * 256 + lane * 16), (LAS unsigned*)(lds + sl_ + 10240), 16, 0, 0); } while (0)
        for (int c = 0; c < R2_PD; ++c) R2_ISSUE_B(c);
        asm volatile("s_waitcnt vmcnt(45)" ::: "memory");
        __builtin_amdgcn_s_barrier();
        for (int c = 0; c < NCHUNK; ++c) { R2_ISSUE_B(c + R2_PD); asm volatile("s_waitcnt vmcnt(45)" ::: "memory"); __builtin_amdgcn_s_barrier(); }
        asm volatile("s_waitcnt vmcnt(0)" ::: "memory");
#undef R2_ISSUE_B
    } else if (wave == 0) {
        const int swi = (l15 >> 1) & 7;
        unsigned char* sg = ws + WS_P + (size_t)(b * SEQ + 16 * ig + l15) * (NPC * 2) + h * 128 + 16 * q;
        f32x4 S[4];
#pragma unroll
        for (int mt = 0; mt < 4; ++mt) S[mt] = (f32x4){0.f, 0.f, 0.f, 0.f};
        asm volatile("" ::: "memory"); __builtin_amdgcn_s_barrier(); asm volatile("" ::: "memory");
        for (int c = 0; c < NCHUNK; ++c) {
            ldsp slot = lds + (c % R2_NS) * R2_SLOT;
            bf16x8 sb[2]; sb[0] = pack8(S[0], S[1]); sb[1] = pack8(S[2], S[3]);
            { unsigned char* sp = sg + (size_t)c * 64 * (NPC * 2); *(bf16x8*)sp = sb[0]; *(bf16x8*)(sp + 64) = sb[1]; }
            f32x4 aS[4];
#pragma unroll
            for (int mt = 0; mt < 4; ++mt) { const int po = l15 * 128 + (((2 * mt + (q >> 1)) ^ swi) * 16) + 8 * (q & 1);
                aS[mt] = *(LAS const f32x4*)(slot + 10240 + (16 * mt + 4 * q) * 4) * S[mt] + unpack4(*(LAS const u32x2*)(slot + 8192 + po)); }
#pragma unroll
            for (int ks = 0; ks < 2; ++ks)
#pragma unroll
                for (int mt = 0; mt < 4; ++mt) { const int jr = 16 * mt + l15; const bf16x8 pa = *(LAS const bf16x8*)(slot + jr * 128 + (((4 * ks + q) ^ ((jr >> 1) & 7)) * 16)); aS[mt] = mfma16(pa, sb[ks], aS[mt]); }
#pragma unroll
            for (int mt = 0; mt < 4; ++mt) S[mt] = aS[mt];
            asm volatile("s_waitcnt lgkmcnt(0)" ::: "memory"); __builtin_amdgcn_s_barrier(); asm volatile("" ::: "memory");
        }
    } else {
        for (int c = 0; c <= NCHUNK; ++c) __builtin_amdgcn_s_barrier();
    }
    WG_BAR();
}

__device__ __forceinline__ void r3_task(const Args& a, int l, int task, int lane) {
    unsigned char* ws = a.ws; const bf16_t* P = (const bf16_t*)(ws + WS_P); bf16_t* Y = (bf16_t*)(ws + WS_H);
    const int u = task >> 2, tt = task & 3, b = u >> 10, h = (u >> 7) & 7, c = u & 127, row0 = b * SEQ + c * 64, l15 = lane & 15, q = lane >> 4;
    const unsigned char* Du = ws + WS_D + (size_t)u * 32768;
    const int tl = 16 * tt + l15, row = row0 + tl, swt = (tl >> 1) & 7;
    bf16x8 rb[2];
#pragma unroll
    for (int ks = 0; ks < 2; ++ks) rb[ks] = *(const bf16x8*)(Du + 8192 + tl * 128 + (((4 * ks + q) ^ swt) * 16));
    f32x4 acc[4];
#pragma unroll
    for (int mt = 0; mt < 4; ++mt) { const int i = 16 * mt + l15; const unsigned char* sp = (const unsigned char*)P + (size_t)(row0 + i) * (NPC * 2) + h * 128 + 16 * q;
        const bf16x8 s0 = *(const bf16x8*)sp, s1 = *(const bf16x8*)(sp + 64);
        acc[mt] = unpack4(*(const u32x2*)(Du + 24576 + tl * 128 + (((2 * mt + (q >> 1)) ^ swt) * 16) + 8 * (q & 1)));
        acc[mt] = mfma16(s0, rb[0], acc[mt]); acc[mt] = mfma16(s1, rb[1], acc[mt]); }
    float s = 0.f;
#pragma unroll
    for (int mt = 0; mt < 4; ++mt) s += (acc[mt][0] + acc[mt][1]) + (acc[mt][2] + acc[mt][3]);
    s += __shfl_xor(s, 16); s += __shfl_xor(s, 32);
    const float mean = s * (1.f / 64.f); float v = 0.f;
#pragma unroll
    for (int mt = 0; mt < 4; ++mt) { acc[mt] = acc[mt] - mean; v += (acc[mt][0] * acc[mt][0] + acc[mt][1] * acc[mt][1]) + (acc[mt][2] * acc[mt][2] + acc[mt][3] * acc[mt][3]); }
    v += __shfl_xor(v, 16); v += __shfl_xor(v, 32);
    const float rstd = __builtin_amdgcn_rsqf(v * (1.f / 64.f) + 64e-5f);
    const bf16_t* pr = P + (size_t)row * NPC; const float bon = *(const float*)((const unsigned char*)pr + PC_PAD * 2 + h * 4); const bool hasprev = (row & (SEQ - 1)) != 0;
    const float* lnw = a.in[15] + l * RWW + h * 64; const float* lnb = a.in[16] + l * RWW + h * 64; const float* mu = a.in[7] + l * SHIFT_COLS + PC_V + h * 64;
#pragma unroll
    for (int mt = 0; mt < 4; ++mt) { const int i0 = 16 * mt + 4 * q;
        const f32x4 vc = unpack4(*(const u32x2*)(pr + PC_V + h * 64 + i0)), vp = hasprev ? unpack4(*(const u32x2*)(pr + PC_V + h * 64 + i0 - NPC)) : (f32x4){0.f, 0.f, 0.f, 0.f}, g = unpack4(*(const u32x2*)(pr + PC_G + h * 64 + i0));
        const f32x4 wv = *(const f32x4*)(lnw + i0), bv = *(const f32x4*)(lnb + i0), mv = *(const f32x4*)(mu + i0);
        const f32x4 vs = vc + (vp - vc) * mv; f32x4 o = acc[mt] * rstd * wv + bv + bon * vs;
#pragma unroll
        for (int r = 0; r < 4; ++r) o[r] = o[r] * g[r] * frcp(1.f + fexp(-g[r]));
        *(u32x2*)(Y + (size_t)row * DM + h * 64 + i0) = pack4(o); }
}

__device__ __forceinline__ void phase_final(const Args& a, int lane, int wave, int G) {
    const int gw = blockIdx.x * 8 + wave, NGW = G * 8; const float* fg = a.in[18];
    for (int m = gw; m < MROWS; m += NGW) {
        f32x4* xr = (f32x4*)(a.out + (size_t)m * DM) + lane; f32x4 v[4]; float s = 0.f;
#pragma unroll
        for (int j = 0; j < 4; ++j) { v[j] = xr[64 * j]; s += (v[j][0] * v[j][0] + v[j][1] * v[j][1]) + (v[j][2] * v[j][2] + v[j][3] * v[j][3]); }
        const float rstd = 1.0f / sqrtf(wave_sum(s) * (1.f / DM) + 1e-6f);
#pragma unroll
        for (int j = 0; j < 4; ++j) { const f32x4 g = *(const f32x4*)(fg + 4 * lane + 256 * j); xr[64 * j] = v[j] * rstd * g; }
    }
}

#define XB_TMO      128
#define XB_XCNT(j)  (256  + 64 * (j))
#define XB_XSUB(j)  (1280 + 64 * (j))
#define XB_XGEN(j)  (2304 + 64 * (j))
#define XB_TOP      3328
#define XB_TOPGEN   3392
#define XCD_BAR_WORDS 3456
#define XB_SPIN_CAP (1u << 18)

__device__ __forceinline__ unsigned xb_ld(unsigned* p)              { return __hip_atomic_load(p, __ATOMIC_RELAXED, __HIP_MEMORY_SCOPE_AGENT); }
__device__ __forceinline__ unsigned xb_add(unsigned* p, unsigned v) { return __hip_atomic_fetch_add(p, v, __ATOMIC_RELAXED, __HIP_MEMORY_SCOPE_AGENT); }
__device__ __forceinline__ unsigned xb_xcc_id() { return (unsigned)__builtin_amdgcn_s_getreg((3 << 11) | 20) & 0xFu; }
#define XB_SPIN(cond, bar) do { unsigned _sp = 0; while (cond) { __builtin_amdgcn_s_sleep(1); \
    if ((++_sp & 255u) == 0u) { if (xb_ld(&(bar)[XB_TMO])) break; if (_sp > XB_SPIN_CAP) { atomicAdd(&(bar)[XB_TMO], 1u); break; } } } } while (0)

struct XcdBarrier {
    unsigned* bar; unsigned x;
    volatile LAS unsigned* st;
};

__device__ __forceinline__ XcdBarrier xcd_barrier_post(unsigned* bar, volatile LAS unsigned* st) {
    XcdBarrier b; b.bar = bar; b.x = xb_xcc_id(); b.st = st;
    if (threadIdx.x == 0) (void)xb_add(&bar[XB_XCNT(b.x)], 1u);
    return b;
}
__device__ __forceinline__ void xcd_barrier_complete(unsigned* bar, unsigned x, unsigned& nloc, unsigned& nx) {
    const unsigned G = gridDim.x * gridDim.y * gridDim.z;
    unsigned sum, cnt, mine, sp = 0u;
    for (;;) {
        sum = 0u; cnt = 0u; mine = 0u;
#pragma unroll
        for (unsigned j = 0; j < 16; ++j) { const unsigned c = xb_ld(&bar[XB_XCNT(j)]); sum += c; cnt += (c > 0u) ? 1u : 0u; mine = (j == x) ? c : mine; }
        if (sum == G) break;
        __builtin_amdgcn_s_sleep(1);
        if ((++sp & 255u) == 0u) { if (xb_ld(&bar[XB_TMO])) break; if (sp > XB_SPIN_CAP) { atomicAdd(&bar[XB_TMO], 1u); break; } }
    }
    nloc = mine > 0u ? mine : 1u; nx = cnt > 0u ? cnt : 1u;
}

__device__ __forceinline__ void xcd_barrier(const XcdBarrier& b) {
    asm volatile("s_waitcnt vmcnt(0)" ::: "memory");
    __syncthreads();
    if (threadIdx.x == 0) {
        unsigned* bar = b.bar;
        __builtin_amdgcn_s_waitcnt(0);
        unsigned nloc = b.st[0], nx = b.st[1];
        if (nloc == 0u) { xcd_barrier_complete(bar, b.x, nloc, nx); b.st[0] = nloc; b.st[1] = nx; }
        const unsigned old = xb_add(&bar[XB_XSUB(b.x)], 1u);
        const unsigned gen = old / nloc;
        if (old + 1u == (gen + 1u) * nloc) {
            __builtin_amdgcn_fence(__ATOMIC_RELEASE, "agent");
            asm volatile("s_waitcnt vmcnt(0)" ::: "memory");
            const unsigned og = xb_add(&bar[XB_TOP], 1u);
            const unsigned tg = og / nx;
            if (og + 1u == (tg + 1u) * nx) xb_add(&bar[XB_TOPGEN], 1u);
            else XB_SPIN(xb_ld(&bar[XB_TOPGEN]) == tg, bar);
            __builtin_amdgcn_fence(__ATOMIC_ACQUIRE, "agent");
            xb_add(&bar[XB_XGEN(b.x)], 1u);
            asm volatile("s_waitcnt vmcnt(0)" ::: "memory");
        } else {
            XB_SPIN(xb_ld(&bar[XB_XGEN(b.x)]) == gen, bar);
            __builtin_amdgcn_fence(__ATOMIC_ACQUIRE, "agent");
            asm volatile("s_waitcnt vmcnt(0)" ::: "memory");
        }
    }
    __syncthreads();
}

#ifndef MK_PER_PHASE
#define MK_PER_PHASE 0
#endif
#ifndef PHMASK
#define PHMASK 0x1ff
#endif
#ifndef DUPMASK
#define DUPMASK 0
#endif
#if MK_PER_PHASE
#define RUN(k) (a.ph_lo <= (k) && (k) < a.ph_hi)
#define SEAM(k) do { } while (0)
#else
#define RUN(k) true
#define SEAM(k) xcd_barrier(bar)
#endif
__global__ void __launch_bounds__(512, 2) fwd_kernel(Args a) {
    extern __shared__ __attribute__((aligned(16))) unsigned char lds_raw[];
    ldsp lds = (ldsp)lds_raw;
    cg::grid_group grid = cg::this_grid();
    int tid = threadIdx.x, lane = tid & 63, wave = __builtin_amdgcn_readfirstlane(tid >> 6); const int G = gridDim.x;
#define FRESH() do { tid = threadIdx.x; asm volatile("" : "+v"(tid)); lane = tid & 63; wave = __builtin_amdgcn_readfirstlane(tid >> 6); } while (0)
    unsigned char* ws = a.ws;
    if (threadIdx.x < 2) ((volatile LAS unsigned*)(lds + LDS_BYTES - 16))[threadIdx.x] = 0u;
    __syncthreads();
    if (a.ph_hi == 0x7fffffff) grid.sync();
    const XcdBarrier bar = xcd_barrier_post((unsigned*)(ws + 806912), (volatile LAS unsigned*)(lds + LDS_BYTES - 16));
#ifdef TPROBE
    unsigned long long* tsb = (unsigned long long*)(ws + 802816);
#define STAMP(k) do { if (blockIdx.x == 0 && threadIdx.x == 0) tsb[k] = __builtin_amdgcn_s_memrealtime(); } while (0)
#else
#define STAMP(k) do { } while (0)
#endif
    STAMP(0);
    if (RUN(0)) { for (int rep = 0; rep < ((DUPMASK & 1) ? 2 : 1); ++rep) phase_p0(a, lds, tid, lane, wave, G); }
    { constexpr int l = 0;
        const int pb = 1 + 6 * l;
        const float* xin = l == 0 ? a.in[0] : a.out;
        SEAM(pb); FRESH(); STAMP(1 + 8 * l);
        if (RUN(pb)) { for (int rep = 0; rep < ((DUPMASK & 4) ? 2 : 1); ++rep) phase_h(a, lds, l, xin, tid, lane, wave, G); }
        SEAM(pb + 1); FRESH(); STAMP(2 + 8 * l);
        if (RUN(pb + 1)) { for (int rep = 0; rep < ((DUPMASK & 8) ? 2 : 1); ++rep) { pg8::Gemm g{(const bf16_t*)(ws + WS_H), (const bf16_t*)(ws + WS_WIN) + (size_t)l * NPC * DM, MROWS, NPC, DM}; pg8::StaticOrder S; S.init(MROWS, NPC, G, (int)blockIdx.x);
            pg8::EpiBf16 E{(bf16_t*)(ws + WS_P), NPC}; pg8::gemm_phase<pg8::EpiBf16, pg8::StaticOrder, true, true>(lds, g, S, E); } }
        SEAM(pb + 2); FRESH(); STAMP(3 + 8 * l);
        if (RUN(pb + 2)) {
            for (int rep = 0; rep < ((DUPMASK & 16) ? 2 : 1); ++rep) { u32x4 rc[5], rp[5]; r1_load(a, l, blockIdx.x, tid, rc, rp); for (int u = blockIdx.x; u < 2048; u += G) r1_unit(a, lds, l, u, u + G < 2048 ? u + G : -1, tid, lane, wave, rc, rp); }
        }
        SEAM(pb + 3); FRESH(); STAMP(5 + 8 * l);
        if (RUN(pb + 3)) { for (int rep = 0; rep < ((DUPMASK & 64) ? 2 : 1); ++rep) { if (blockIdx.x < 64) { phase_r2(a, lds, tid, lane, wave); { const int task = 3584 + blockIdx.x * 8 + wave; sb_task(a, lds + wave * 4608, l, task, lane); } }
            else { const int gw = (blockIdx.x - 64) * 8 + wave, NGW = (G - 64) * 8; for (int task = gw; task < 3584; task += NGW) sb_task(a, lds + wave * 4608, l, task, lane); } } }
        SEAM(pb + 4); FRESH(); STAMP(6 + 8 * l);
        if (RUN(pb + 4)) { for (int rep = 0; rep < ((DUPMASK & 128) ? 2 : 1); ++rep) { const int gw = blockIdx.x * 8 + wave, NGW = G * 8; for (int task = gw; task < 8192; task += NGW) r3_task(a, l, task, lane); } }
        SEAM(pb + 5); FRESH(); STAMP(7 + 8 * l);
        if (RUN(pb + 5)) { for (int rep = 0; rep < ((DUPMASK & 256) ? 2 : 1); ++rep) { pg8::Gemm g{(const bf16_t*)(ws + WS_H), (const bf16_t*)(ws + WS_WOUT) + (size_t)l * DM * DM, MROWS, DM, DM}; pg8::StaticOrder S; S.init(MROWS, DM, G, (int)blockIdx.x);
            pg8::EpiRes E{xin, a.out, (const float*)(ws + WS_GATE) + l * 2048}; pg8::gemm_phase<pg8::EpiRes, pg8::StaticOrder, true, true>(lds, g, S, E); } }
        }
    { constexpr int l = 1;
        const int pb = 1 + 6 * l;
        const float* xin = l == 0 ? a.in[0] : a.out;
        SEAM(pb); FRESH(); STAMP(1 + 8 * l);
        if (RUN(pb)) { if (PHMASK & 4) phase_h(a, lds, l, xin, tid, lane, wave, G); }
        SEAM(pb + 1); FRESH(); STAMP(2 + 8 * l);
        if (RUN(pb + 1)) { if (PHMASK & 8) { pg8::Gemm g{(const bf16_t*)(ws + WS_H), (const bf16_t*)(ws + WS_WIN) + (size_t)l * NPC * DM, MROWS, NPC, DM}; pg8::StaticOrder S; S.init(MROWS, NPC, G, (int)blockIdx.x);
            pg8::EpiBf16 E{(bf16_t*)(ws + WS_P), NPC}; pg8::gemm_phase<pg8::EpiBf16, pg8::StaticOrder, true, true>(lds, g, S, E); } }
        SEAM(pb + 2); FRESH(); STAMP(3 + 8 * l);
        if (RUN(pb + 2)) {
            if (PHMASK & 16) { u32x4 rc[5], rp[5]; r1_load(a, l, blockIdx.x, tid, rc, rp); for (int u = blockIdx.x; u < 2048; u += G) r1_unit(a, lds, l, u, u + G < 2048 ? u + G : -1, tid, lane, wave, rc, rp); }
        }
        SEAM(pb + 3); FRESH(); STAMP(5 + 8 * l);
        if (RUN(pb + 3)) { if (PHMASK & 64) { if (blockIdx.x < 64) { phase_r2(a, lds, tid, lane, wave); { const int task = 3584 + blockIdx.x * 8 + wave; sb_task(a, lds + wave * 4608, l, task, lane); } }
            else { const int gw = (blockIdx.x - 64) * 8 + wave, NGW = (G - 64) * 8; for (int task = gw; task < 3584; task += NGW) sb_task(a, lds + wave * 4608, l, task, lane); } } }
        SEAM(pb + 4); FRESH(); STAMP(6 + 8 * l);
        if (RUN(pb + 4)) { if (PHMASK & 128) { const int gw = blockIdx.x * 8 + wave, NGW = G * 8; for (int task = gw; task < 8192; task += NGW) r3_task(a, l, task, lane); } }
        SEAM(pb + 5); FRESH(); STAMP(7 + 8 * l);
        if (RUN(pb + 5)) { if (PHMASK & 256) { pg8::Gemm g{(const bf16_t*)(ws + WS_H), (const bf16_t*)(ws + WS_WOUT) + (size_t)l * DM * DM, MROWS, DM, DM}; pg8::StaticOrder S; S.init(MROWS, DM, G, (int)blockIdx.x);
            pg8::EpiRes E{xin, a.out, (const float*)(ws + WS_GATE) + l * 2048}; pg8::gemm_phase<pg8::EpiRes, pg8::StaticOrder, true, true>(lds, g, S, E); } }
        }
    SEAM(13); FRESH(); STAMP(17);
    if (RUN(13)) { if (PHMASK & 2) phase_final(a, lane, wave, G); }
#ifdef TPROBE
    STAMP(18); grid.sync();
    { float A_ = (float)(tsb[TP_A1] - tsb[TP_A0]) * 0.01f, B_ = (float)(tsb[TP_B1] - tsb[TP_B0]) * 0.01f;
      A_ = __expf(0.13976f * floorf(__logf(fmaxf(A_, 1.f)) / 0.13976f + 0.5f)); B_ = __expf(0.13976f * floorf(__logf(fmaxf(B_, 1.f)) / 0.13976f + 0.5f));
      for (int i = blockIdx.x * 512 + threadIdx.x; i < (1 << 20); i += G * 512) a.out[i] = i == 0 ? A_ * 1000.f : B_; }
#endif
}

#ifdef DBG_CHECK
#define ACC(k, got, want) do { const float g_ = (got), w_ = (want); const float d_ = g_ - w_; nm[k] += (d_ == d_) ? fminf(d_ * d_, 1e30f) : 1e30f; dn[k] += w_ * w_; } while (0)
__device__ __forceinline__ unsigned hsh(unsigned x) { x ^= x >> 16; x *= 0x7feb352du; x ^= x >> 15; x *= 0x846ca68bu; x ^= x >> 16; return x; }
__device__ __forceinline__ float dbg_silu(float x) { return x / (1.f + __expf(-x)); }
__device__ __forceinline__ float dbg_mod(const Args& a, int l, int b, int n) { float s = a.in[4][l * 3072 + n]; for (int k = 0; k < 1024; ++k) s += dbg_silu(a.in[1][b * 1024 + k]) * a.in[3][((size_t)l * 1024 + k) * 3072 + n]; return s; }
#define sh(col) (bf2f(pr[col]) + ((t > 0 ? bf2f(pr[(col) - NPC]) : 0.f) - bf2f(pr[col])) * mu[col])
#define DQ(Dp, mat, row, el) bf2f(*(const bf16_t*)((Dp) + (mat) * 8192 + (row) * 128 + ((((el) >> 3) ^ (((row) >> 1) & 7)) * 16) + ((el) & 7) * 2))
#define KP(jj) (32 * ((jj) >> 5) + 8 * (((jj) >> 2) & 3) + 4 * (((jj) >> 4) & 1) + ((jj) & 3))
constexpr int T0 = 7992;
__global__ void __launch_bounds__(256) dbg_check(Args a, int stage) {
    __shared__ float red[256]; __shared__ float st[64 * 65]; __shared__ float vec[8][64]; __shared__ float s64[64 * 65];
    float nm[16], dn[16];
#pragma unroll
    for (int i = 0; i < 16; ++i) { nm[i] = 0.f; dn[i] = 0.f; }
    unsigned char* ws = a.ws; float* err = (float*)(ws + WS_DBG); const int tid = threadIdx.x; float e = 0.f;
    const bf16_t* P = (const bf16_t*)(ws + WS_P); const bf16_t* Hb = (const bf16_t*)(ws + WS_H);
    if (stage == 1) {
        if (tid < 32) err[tid] = 0.f; __syncthreads();
        for (int s = tid; s < 4096; s += 256) { const unsigned r = hsh(s * 2654435761u + 17u); const int l = r & 1, n = (r >> 1) % NPC, k = (r >> 14) & 1023;
            const int sn = n < PC_PAD ? n : (n < PC_SQ ? -1 : n - 128); const float want = sn < 0 ? 0.f : bf2f(f2bf(a.in[5][((size_t)l * 1024 + k) * IN_COLS + sn]));
            ACC(1, bf2f(((const bf16_t*)(ws + WS_WIN))[((size_t)l * NPC + n) * 1024 + k]), want);
            const int n2 = n & 1023; ACC(1, bf2f(((const bf16_t*)(ws + WS_WOUT))[((size_t)l * 1024 + n2) * 1024 + k]), bf2f(f2bf(a.in[6][((size_t)l * 1024 + k) * 1024 + n2]))); }
    } else if (stage == 2) {
        for (int s = tid; s < 256; s += 256) { const unsigned r = hsh(s + 99u); const int m = r % MROWS, k = (r >> 15) & 1023, b = m >> 13;
            float ss = 0.f; for (int j = 0; j < 1024; ++j) { const float x = a.in[0][(size_t)m * 1024 + j]; ss += x * x; }
            const float rstd = 1.f / sqrtf(ss / 1024.f + 1e-6f); const float want = a.in[0][(size_t)m * 1024 + k] * rstd * a.in[2][k] * (1.f + dbg_mod(a, 0, b, 1024 + k)) + dbg_mod(a, 0, b, k);
            ACC(2, bf2f(Hb[(size_t)m * 1024 + k]), want);
            ACC(2, ((const float*)(ws + WS_GATE))[b * 1024 + k], dbg_mod(a, 0, b, 2048 + k)); }
    } else if (stage == 3) {
        for (int s = tid; s < 2048; s += 256) { const unsigned r = hsh(s + 777u); const int m = r % MROWS, n = (r >> 15) % NPC; float acc = 0.f;
            for (int k = 0; k < 1024; ++k) acc += bf2f(Hb[(size_t)m * 1024 + k]) * bf2f(((const bf16_t*)(ws + WS_WIN))[(size_t)n * 1024 + k]);
            ACC(3, bf2f(P[(size_t)m * NPC + n]), acc); }
    } else if (stage == 4) {
        const unsigned r = hsh(tid + 4242u); const int b = r & 1, h = (r >> 1) & 7; int t = (r >> 4) & 8191; if (tid < 40) t = tid;
        const bf16_t* qp = P + (size_t)(b * SEQ + t) * NPC + PC_SQ + h * 64; float* o = st + (tid & 63) * 65; for (int d = 0; d < 64; ++d) o[d] = 0.f; float after = 0.f; if (tid < 64) {
        for (int s = t - 1; s >= 0 && after > -110.f; --s) { const bf16_t* kp = P + (size_t)(b * SEQ + s) * NPC + PC_SK + h * 64; float z = 0.f; for (int d = 0; d < 64; ++d) z += bf2f(qp[d]) * bf2f(kp[d]); z *= 0.125f;
            const float sp = fmaxf(z, 0.f) + __logf(1.f + __expf(-fabsf(z))); const float w = __expf(z - sp + after); const bf16_t* vp = P + (size_t)(b * SEQ + s) * NPC + PC_SV + h * 64;
            for (int d = 0; d < 64; ++d) o[d] += w * bf2f(vp[d]); after -= sp; }
        float ss = 0.f; for (int d = 0; d < 64; ++d) ss += o[d] * o[d]; const float rms = 1.f / sqrtf(ss / 64.f + 1e-6f);
        for (int d = 0; d < 64; ++d) { const float g = bf2f(P[(size_t)(b * SEQ + t) * NPC + PC_SG + h * 64 + d]); const float want = o[d] * rms * a.in[17][h * 64 + d] * dbg_silu(g);
            ACC(4, bf2f(Hb[(size_t)(b * SEQ + t) * 1024 + 512 + h * 64 + d]), want); } }
    } else if (stage == 5 || stage == 6) {
        if (tid < 64) { const int b = stage == 5 ? 0 : 1, h = stage == 5 ? 0 : 5, j = tid, jg = h * 64 + j; const float* mu = a.in[7];
            for (int x = 0; x < 64; ++x) st[tid * 65 + x] = 0.f;
            float pd = 1.f;
            float* expy = (float*)(ws + WS_DBG + 4096) + (stage - 5) * 200 * 64;
            for (int t = 0; t < T0 + 200; ++t) { const bf16_t* pr = P + (size_t)(b * SEQ + t) * NPC;
                const float rr = sh(PC_R + jg), kr = sh(PC_K + jg), vv = sh(PC_V + jg); float wa = a.in[8][jg], aa = a.in[10][jg];
                for (int m = 0; m < 64; ++m) { wa += tanh_f(sh(PC_ZW + m)) * a.in[9][(size_t)m * 512 + jg]; aa += sh(PC_ZA + m) * a.in[11][(size_t)m * 512 + jg]; }
                const float sp = fmaxf(-wa, 0.f) + __logf(1.f + __expf(-fabsf(wa))); const float dec = __expf(-__expf(-sp - 0.5f)); const float av = 1.f / (1.f + __expf(-aa));
                float kk = kr * a.in[12][jg]; vec[6][j] = kk * kk; __syncthreads(); float n2 = 0.f; for (int x = 0; x < 64; ++x) n2 += vec[6][x]; kk *= 1.f / sqrtf(fmaxf(n2, 1e-24f));
                const float kp = kr * (1.f + (av - 1.f) * a.in[13][jg]);
                vec[0][j] = rr; vec[1][j] = dec; vec[2][j] = kp; vec[3][j] = vv; vec[4][j] = kk; vec[5][j] = kk * av; vec[7][j] = rr * kp * a.in[14][jg]; __syncthreads();
                float sa = 0.f; for (int x = 0; x < 64; ++x) sa += st[tid * 65 + x] * -vec[4][x];
                float y = 0.f; for (int x = 0; x < 64; ++x) { float s2 = st[tid * 65 + x] * vec[1][x] + sa * vec[5][x] + vec[3][tid] * vec[2][x]; st[tid * 65 + x] = s2; y += s2 * vec[0][x]; }
                float bon = 0.f; for (int x = 0; x < 64; ++x) bon += vec[7][x];
                __syncthreads(); vec[6][j] = y; __syncthreads(); float mean = 0.f; for (int x = 0; x < 64; ++x) mean += vec[6][x]; mean /= 64.f; float var = 0.f; for (int x = 0; x < 64; ++x) var += (vec[6][x] - mean) * (vec[6][x] - mean); var /= 64.f;
                const float yn = (y - mean) / sqrtf(var + 64e-5f) * a.in[15][jg] + a.in[16][jg] + bon * vv; const float g = bf2f(pr[PC_G + jg]);
                if (t >= T0) expy[(t - T0) * 64 + j] = y; if (t >= T0) expy[2 * 200 * 64 + (t - T0) * 64 + j] = yn * dbg_silu(g);
                { const int u0 = (b * 8 + h) * 128; const unsigned char* D0 = ws + WS_D + (size_t)u0 * 32768; const unsigned char* D1 = D0 + 32768; const int i = tid;
                  pd *= dec;
                  if (t < 64) ACC(11, DQ(D0, 3, i, t), y);
                  if (t == 63) { for (int x = 0; x < 64; ++x) { ACC(10, DQ(D0, 2, i, x), st[i * 65 + x]); s64[i * 65 + x] = st[i * 65 + x]; }
                      ACC(12, ((const float*)(ws + WS_GAM))[(size_t)u0 * 64 + j], pd); }
                  if (t >= 64 && t < 128) { float yp = DQ(D1, 3, i, t - 64); for (int x = 0; x < 64; ++x) yp += DQ(D1, 1, t - 64, KP(x)) * s64[i * 65 + x]; ACC(15, yp, y); }
                  if (t == 127) { for (int jp = 0; jp < 64; ++jp) { float sp2 = ((const float*)(ws + WS_GAM))[(size_t)(u0 + 1) * 64 + jp] * s64[i * 65 + jp] + DQ(D1, 2, i, jp);
                          for (int x = 0; x < 64; ++x) sp2 += DQ(D1, 0, jp, KP(x)) * s64[i * 65 + x]; ACC(14, sp2, st[i * 65 + jp]); } }
                }
                __syncthreads(); }
            }
    } else if (stage == 7 || stage == 8) {
        const float* expy = (const float*)(ws + WS_DBG + 4096);
        for (int which = 0; which < 2; ++which) { const int b = which ? 1 : 0, h = which ? 5 : 0;
            for (int s = tid; s < 200 * 64; s += 256) { const int t = s >> 6, j = s & 63;
                if (stage == 7) { const float gv = *(const float*)((const unsigned char*)P + (size_t)(b * SEQ + T0 + t) * NPC * 2 + (h * 64 + j) * 4); if (t < 64) ACC(7, gv, expy[which * 200 * 64 + s]); else ACC(13, gv, expy[which * 200 * 64 + s]); }
                else ACC(8, bf2f(Hb[(size_t)(b * SEQ + T0 + t) * 1024 + h * 64 + j]), expy[2 * 200 * 64 + which * 200 * 64 + s]); } }
    } else if (stage == 9) {
        for (int s = tid; s < 1024; s += 256) { const unsigned r = hsh(s + 31337u); const int m = r % MROWS, n = (r >> 15) & 1023, b = m >> 13; float acc = 0.f;
            for (int k = 0; k < 1024; ++k) acc += bf2f(Hb[(size_t)m * 1024 + k]) * bf2f(((const bf16_t*)(ws + WS_WOUT))[(size_t)n * 1024 + k]);
            ACC(9, a.out[(size_t)m * 1024 + n], a.in[0][(size_t)m * 1024 + n] + ((const float*)(ws + WS_GATE))[b * 1024 + n] * acc); }
    } else if (stage == 20) {
        const unsigned char* dump = ws + WS_DUMP; float* REF = (float*)(ws + WS_DUMP + 156672);
        float* Rr = REF, *Rc = REF + 4096, *Rkp = REF + 8192, *Rv = REF + 12288, *Rkk = REF + 16384, *Ra = REF + 20480;
        { const int t = tid >> 2, jq = tid & 3; const bf16_t* pr = P + (size_t)t * NPC; const float* mu = a.in[7]; float n2 = 0.f;
          for (int jj = 0; jj < 16; ++jj) { const int j = jq * 16 + jj; const float kr = sh(PC_K + j); const float kk = kr * a.in[12][j]; n2 += kk * kk; }
          n2 += __shfl_xor(n2, 1); n2 += __shfl_xor(n2, 2); const float rn = 1.f / sqrtf(fmaxf(n2, 1e-24f));
          for (int jj = 0; jj < 16; ++jj) { const int j = jq * 16 + jj; const float rr = sh(PC_R + j), kr = sh(PC_K + j), vv = sh(PC_V + j); float wa = a.in[8][j], aa = a.in[10][j];
              for (int m = 0; m < 64; ++m) { wa += tanh_f(sh(PC_ZW + m)) * a.in[9][(size_t)m * 512 + j]; aa += sh(PC_ZA + m) * a.in[11][(size_t)m * 512 + j]; }
              const float sp = fmaxf(-wa, 0.f) + __logf(1.f + __expf(-fabsf(wa))); const float av = 1.f / (1.f + __expf(-aa));
              Rr[t * 64 + j] = rr; Rc[t * 64 + j] = -__expf(-sp - 0.5f); Rkp[t * 64 + j] = kr * (1.f + (av - 1.f) * a.in[13][j]); Rv[t * 64 + j] = vv; Rkk[t * 64 + j] = kr * a.in[12][j] * rn; Ra[t * 64 + j] = av; } }
        __threadfence(); __syncthreads();
        if (tid < 64) { float c = 0.f; for (int t = 0; t < 64; ++t) { c += Rc[t * 64 + tid]; Rc[t * 64 + tid] = c; } }
        __threadfence(); __syncthreads();
#define DM_(off, row, col) bf2f(*(const bf16_t*)(dump + (off) + (row) * 144 + (col) * 2))
        for (int s = tid; s < 4096; s += 256) { const int t = s >> 6, j = s & 63; const float ci = Rc[s], ce = t ? Rc[s - 64] : 0.f, ct = Rc[63 * 64 + j], kk = Rkk[s], av = Ra[s], kp = Rkp[s];
            const float Ag = -kk * __expf(ce), Rg = Rr[s] * __expf(ci), Bg = kk * av * __expf(-ci), Kg = kp * __expf(-ci);
            ACC(1, DM_(0, t, j), Ag); ACC(2, DM_(9216, t, j), Rg); ACC(3, DM_(18432, t, j), Bg); ACC(4, DM_(27648, t, j), Kg);
            ACC(5, DM_(36864, j, t), Ag); ACC(6, DM_(46080, j, t), kk * av * __expf(ct - ci)); ACC(6, DM_(55296, j, t), kp * __expf(ct - ci)); ACC(7, DM_(64512, j, t), Rv[s]); }
        for (int s = tid; s < 4096; s += 256) { const int t = s >> 6, u_ = s & 63; float ab = 0.f, ak = 0.f, rb = 0.f, rk = 0.f;
            for (int j = 0; j < 64; ++j) { const float ag = DM_(0, t, j), rg = DM_(9216, t, j), bg = DM_(18432, u_, j), kg = DM_(27648, u_, j); ab += ag * bg; ak += ag * kg; rb += rg * bg; rk += rg * kg; }
            if (!(u_ < t)) { ab = 0.f; ak = 0.f; } if (!(u_ <= t)) { rb = 0.f; rk = 0.f; }
            ACC(8, DM_(73728, t, u_), ab); ACC(8, DM_(73728 + 9216, u_, t), ab); ACC(9, DM_(92160, t, u_), ak); ACC(9, DM_(92160 + 9216, t, u_), rb); ACC(9, DM_(92160 + 18432, t, u_), rk); }
        if (tid < 64) { for (int t = 0; t < 64; ++t) { float v = (t == tid) ? 1.f : 0.f; for (int k = 0; k < t; ++k) v += DM_(73728, t, k) * st[k * 65 + tid]; st[t * 65 + tid] = v; } }
        __syncthreads();
        for (int s = tid; s < 4096; s += 256) { const int t = s >> 6, u_ = s & 63; ACC(10, DM_(119808, t, u_), st[t * 65 + u_]);
            float akv = 0.f; for (int k = 0; k < 64; ++k) akv += DM_(92160, u_, k) * DM_(64512, t, k);
            ACC(11, DM_(129024, t, u_), akv); ACC(14, DM_(-49152, t, u_), akv); }
        for (int s = tid; s < 8192; s += 256) { const int n = s >> 6, t = s & 63; float x = 0.f; for (int k = 0; k < 64; ++k) x += DM_(119808, t, k) * (n < 64 ? DM_(36864, n, k) : DM_(129024, n - 64, k));
            ACC(12, DM_(138240, n, t), x); }
        { const unsigned char* D0 = ws + WS_D;
          for (int s = tid; s < 4096; s += 256) { const int r_ = s >> 6, c_ = s & 63; float pp = 0.f, y0 = 0.f;
              for (int k = 0; k < 64; ++k) { pp += DM_(46080, r_, k) * DM_(138240, c_, k); y0 += DM_(92160 + 9216, c_, k) * DM_(138240, 64 + r_, k) + DM_(92160 + 18432, c_, k) * DM_(64512, r_, k); }
              ACC(13, DQ(D0, 0, r_, KP(c_)), pp); ACC(13, DQ(D0, 3, r_, c_), y0); } }
    } else if (stage == 30) {
        for (int s = tid; s < 256; s += 256) { const unsigned r = hsh(s + 555u); const int m = r % MROWS, k = (r >> 15) & 1023, b = m >> 13;
            float ss = 0.f; for (int j = 0; j < 1024; ++j) { const float x = a.out[(size_t)m * 1024 + j]; ss += x * x; }
            const float rstd = 1.f / sqrtf(ss / 1024.f + 1e-6f); const float want = a.out[(size_t)m * 1024 + k] * rstd * a.in[2][1024 + k] * (1.f + dbg_mod(a, 1, b, 1024 + k)) + dbg_mod(a, 1, b, k);
            ACC(5, bf2f(Hb[(size_t)m * 1024 + k]), want);
            ACC(5, ((const float*)(ws + WS_GATE))[2048 + b * 1024 + k], dbg_mod(a, 1, b, 2048 + k)); }
    } else if (stage == 31) {
        for (int s = tid; s < 256; s += 256) { const unsigned r = hsh(s + 888u); const int m = r % MROWS; float ss = 0.f;
            for (int j = 0; j < 1024; ++j) { const float x = a.out[(size_t)m * 1024 + j] / a.in[18][j]; ss += x * x; } ACC(6, ss / 1024.f, 1.f); }
    } else if (stage == 99) {
        for (int i = tid; i < MROWS * DM; i += 256) a.out[i] = 0.f;
        __syncthreads();
        if (tid == 0) { for (int k = 1; k <= 14; ++k) if (!(err[16 + k] < 0.03f)) { a.out[0] = (float)(10 + k) * 1e6f; return; } }
        if (tid == 0) { const float th[9] = {0.003f, 0.005f, 0.01f, 0.02f, 0.03f, 0.05f, 0.1f, 0.3f, 1.0f}; int c8 = 9, c13 = 9, c5 = 9, c6 = 9;
            for (int i = 8; i >= 0; --i) { if (err[8] < th[i]) c8 = i; if (err[13] < th[i]) c13 = i; if (err[5] < th[i]) c5 = i; if (err[6] < th[i]) c6 = i; }
            float pw = 1e6f; for (int z = 0; z < c5 + (c6 > 4 ? 10 : 0); ++z) pw *= 10.f; a.out[0] = (float)(10 * (1 + (c8 > 8 ? 8 : c8)) + c13) * pw; return; }
        if (tid == 0) { const int lo[6] = {7, 13, 10, 11, 12, 14}; const int hi[4] = {15, 8, 9, 0}; int lb = 0, hb = 0;
            for (int i = 0; i < 6; ++i) if (!(err[lo[i]] < 0.03f)) lb |= 1 << i;
            for (int i = 0; i < 3; ++i) if (!(err[hi[i]] < 0.03f)) hb |= 1 << i;
            if (!(err[1] < 0.03f) || !(err[2] < 0.03f) || !(err[3] < 0.03f) || !(err[4] < 0.03f)) hb |= 8;
            if (lb | hb) { float pw = 1e4f; for (int z = 0; z < hb; ++z) pw *= 10.f; a.out[0] = (float)(10 + lb) * pw; } }
        return;
    }
    __syncthreads();
#pragma unroll
    for (int k = 1; k < 16; ++k) { if (stage == 6 && k >= 10) continue; if ((stage == 5 || stage == 6) && k < 10) continue; red[tid] = nm[k]; __syncthreads(); float n_ = 0.f; if (tid == 0) for (int i = 0; i < 256; ++i) n_ += red[i]; __syncthreads(); red[tid] = dn[k]; __syncthreads();
        if (tid == 0) { float d_ = 0.f; for (int i = 0; i < 256; ++i) d_ += red[i]; if (n_ > 0.f || d_ > 0.f) err[(stage == 20 ? 16 : 0) + k] = sqrtf(n_ / (d_ + 1e-30f)); } __syncthreads(); }
}
#endif
extern "C" void kernel_launch(void* const* d_in, const int* in_sizes, int n_in, void* d_out, int out_size, void* d_ws, size_t ws_size, hipStream_t stream) {
    static int grid = 0;
    if (grid == 0) {
        if (n_in != 19 || out_size != MROWS * DM || ws_size < WS_END) { fprintf(stderr, "kernel_launch: unexpected shapes (n_in %d, out %d, ws %zu)\n", n_in, out_size, ws_size); grid = -1; return; }
        int dev = 0, cus = 0, per_cu = 0;
        (void)hipGetDevice(&dev); (void)hipDeviceGetAttribute(&cus, hipDeviceAttributeMultiprocessorCount, dev);
        if (hipFuncSetAttribute((const void*)fwd_kernel, hipFuncAttributeMaxDynamicSharedMemorySize, LDS_BYTES) != hipSuccess) { fprintf(stderr, "kernel_launch: hipFuncSetAttribute failed\n"); grid = -1; return; }
        if (hipOccupancyMaxActiveBlocksPerMultiprocessor(&per_cu, (const void*)fwd_kernel, 512, LDS_BYTES) != hipSuccess || per_cu < 1) { fprintf(stderr, "kernel_launch: occupancy query says %d\n", per_cu); per_cu = 1; }
        (void)hipGetLastError();
        grid = cus * 1;
        if (grid < 16) { grid = -1; return; }
    }
    if (grid < 0) return;
    Args a{};
    for (int i = 0; i < 19; ++i) a.in[i] = (const float*)d_in[i];
    a.out = (float*)d_out; a.ws = (unsigned char*)d_ws;
#if MK_PER_PHASE
    for (int ph = 0; ph < NPHASE; ++ph) { a.ph_lo = ph; a.ph_hi = ph + 1; hipLaunchKernelGGL(fwd_kernel, dim3(grid), dim3(512), LDS_BYTES, stream, a);
#ifdef DBG_CHECK
        if (ph == 0) hipLaunchKernelGGL(dbg_check, dim3(1), dim3(256), 0, stream, a, 1);
        if (ph == 1) hipLaunchKernelGGL(dbg_check, dim3(1), dim3(256), 0, stream, a, 2);
        if (ph == 2) hipLaunchKernelGGL(dbg_check, dim3(1), dim3(256), 0, stream, a, 3);
        if (ph == 3) { hipLaunchKernelGGL(dbg_check, dim3(1), dim3(256), 0, stream, a, 20); hipLaunchKernelGGL(dbg_check, dim3(1), dim3(256), 0, stream, a, 4); hipLaunchKernelGGL(dbg_check, dim3(1), dim3(256), 0, stream, a, 5); hipLaunchKernelGGL(dbg_check, dim3(1), dim3(256), 0, stream, a, 6); }
        if (ph == 4) hipLaunchKernelGGL(dbg_check, dim3(1), dim3(256), 0, stream, a, 7);
        if (ph == 5) hipLaunchKernelGGL(dbg_check, dim3(1), dim3(256), 0, stream, a, 8);
        if (ph == 6) hipLaunchKernelGGL(dbg_check, dim3(1), dim3(256), 0, stream, a, 9);
        if (ph == 7) hipLaunchKernelGGL(dbg_check, dim3(1), dim3(256), 0, stream, a, 30);
        if (ph == NPHASE - 1) { hipLaunchKernelGGL(dbg_check, dim3(1), dim3(256), 0, stream, a, 31); hipLaunchKernelGGL(dbg_check, dim3(1), dim3(256), 0, stream, a, 99); }
#endif
    }
#else
    a.ph_lo = 0; a.ph_hi = NPHASE;
    (void)hipMemsetAsync((unsigned char*)d_ws + 806912, 0, 16384, stream);
    void* args[] = {&a};
    hipError_t e = hipLaunchCooperativeKernel((const void*)fwd_kernel, dim3(grid), dim3(512), args, LDS_BYTES, stream);
    if (e != hipSuccess) fprintf(stderr, "cooperative launch failed: %s (grid %d)\n", hipGetErrorString(e), grid);
#endif
}
```
